# Optimizing an MI355X kernel written in HIP

```python
import math
import jax, jax.numpy as jnp
from jax import lax
import numpy as np

D_MODEL = 2048
BATCH = 4
SEQ = 4096
DEPTH = 2

EPS = 1e-6
N_MOD = 6
SSM_WIDTH = D_MODEL // 2
SSM_GROUP = 16
SSM_GROUPS = SSM_WIDTH // SSM_GROUP
SSM_STATE = 64
HEAD_DIM = 128
ATTN_WIDTH = D_MODEL // 2
ATTN_HEADS = ATTN_WIDTH // HEAD_DIM
DILATED_PATTERNS = ((128, 1), (512, 4), (2048, 16))
BLOCK = 128
IN_SIZES = (SSM_WIDTH, ATTN_WIDTH, ATTN_WIDTH, ATTN_WIDTH, D_MODEL, D_MODEL)
IN_COLS = sum(IN_SIZES)
IN_SPLITS = tuple(int(v) for v in np.cumsum(IN_SIZES)[:-1])
PEER_HEADS = 8
PEER_NKEYS = 128
PEER_EXPERTS = PEER_NKEYS * PEER_NKEYS
PEER_TOPK = 16
PEER_DQ = 256
PEER_CHUNK = 128

kernel_name = 'hybrid_s5_dilated_attn_peer_adaln'


def _rmsnorm(x, gain):
    x32 = x.astype(jnp.float32)
    y = x32 * lax.rsqrt(jnp.mean(x32 * x32, axis=-1, keepdims=True) + EPS)
    return (y * gain.astype(jnp.float32)).astype(x.dtype)


def _complex_affine_combine(e1, e2):
    a1r, a1i, b1r, b1i = e1
    a2r, a2i, b2r, b2i = e2
    ar = a2r * a1r - a2i * a1i
    ai = a2r * a1i + a2i * a1r
    br = a2r * b1r - a2i * b1i + b2r
    bi = a2r * b1i + a2i * b1r + b2i
    return (ar, ai, br, bi)


def _s5_branch(u, lam_re, lam_im, log_dt, b_re, b_im, c_re, c_im, d_skip, w_glu):
    bsz, seq, _ = u.shape
    f32 = jnp.float32
    u32 = u.astype(f32)
    ug = u32.reshape(bsz, seq, SSM_GROUPS, SSM_GROUP)
    dt = jnp.exp(log_dt.astype(f32))[:, None]
    lr, li = lam_re.astype(f32), lam_im.astype(f32)
    mag = jnp.exp(lr * dt)
    a_re = mag * jnp.cos(li * dt)
    a_im = mag * jnp.sin(li * dt)
    inv = 1.0 / (lr * lr + li * li)
    coef_re = ((a_re - 1.0) * lr + a_im * li) * inv
    coef_im = (a_im * lr - (a_re - 1.0) * li) * inv
    br, bi = b_re.astype(f32), b_im.astype(f32)
    bbar_re = coef_re[..., None] * br - coef_im[..., None] * bi
    bbar_im = coef_re[..., None] * bi + coef_im[..., None] * br
    bu_re = jnp.einsum('bsgc,gpc->bsgp', ug, bbar_re)
    bu_im = jnp.einsum('bsgc,gpc->bsgp', ug, bbar_im)
    a_re_t = jnp.broadcast_to(a_re, (1, seq) + a_re.shape)
    a_im_t = jnp.broadcast_to(a_im, (1, seq) + a_im.shape)
    _, _, h_re, h_im = lax.associative_scan(
        _complex_affine_combine, (a_re_t, a_im_t, bu_re, bu_im), axis=1)
    y = (jnp.einsum('bsgp,gcp->bsgc', h_re, c_re.astype(f32))
         - jnp.einsum('bsgp,gcp->bsgc', h_im, c_im.astype(f32)))
    y = y.reshape(bsz, seq, SSM_WIDTH) + d_skip.astype(f32) * u32
    y = jax.nn.gelu(y, approximate=False)
    y = y * jax.nn.sigmoid(y @ w_glu.astype(f32))
    return y.astype(u.dtype)


def _dilated_window(q, k, v, window, dilation):
    bsz, seq, nh, hd = q.shape
    f32 = jnp.float32
    n_back = window // dilation
    sub_len = seq // dilation
    n_blk = -(-sub_len // BLOCK)
    pad = n_blk * BLOCK - sub_len

    def to_sub(t):
        t = t.reshape(bsz, sub_len, dilation, nh, hd).transpose(0, 2, 3, 1, 4)
        t = jnp.pad(t, ((0, 0), (0, 0), (0, 0), (0, pad), (0, 0)))
        return t.reshape(bsz, dilation, nh, n_blk, BLOCK, hd)

    def with_prev(t):
        prev = jnp.pad(t[:, :, :, :-1], ((0, 0), (0, 0), (0, 0), (1, 0), (0, 0), (0, 0)))
        return jnp.concatenate([prev, t], axis=4)

    qb = to_sub(q)
    kk = with_prev(to_sub(k))
    vv = with_prev(to_sub(v))
    s = jnp.einsum('bdhnqe,bdhnke->bdhnqk', qb, kk).astype(f32) * (hd ** -0.5)
    blk = jnp.arange(n_blk)[:, None, None]
    qi = jnp.arange(BLOCK)[None, :, None]
    kj = jnp.arange(2 * BLOCK)[None, None, :]
    dist = BLOCK + qi - kj
    key_pos = (blk - 1) * BLOCK + kj
    valid = (dist >= 0) & (dist <= n_back) & (key_pos >= 0)
    s = jnp.where(valid, s, -jnp.inf)
    m = jnp.max(s, axis=-1, keepdims=True)
    p = jnp.exp(s - m)
    den = jnp.sum(p, axis=-1, keepdims=True)
    o = jnp.einsum('bdhnqk,bdhnke->bdhnqe', p, vv.astype(f32)) / den
    lse = (m + jnp.log(den))[..., 0]

    def from_sub(t):
        t = t.reshape((bsz, dilation, nh, n_blk * BLOCK) + t.shape[5:])[:, :, :, :sub_len]
        t = jnp.moveaxis(t, 3, 1)
        return t.reshape((bsz, seq, nh) + t.shape[4:])

    return from_sub(o), from_sub(lse)


def _dilated_attention(q, k, v):
    bsz, seq, _ = q.shape
    shp = (bsz, seq, ATTN_HEADS, HEAD_DIM)
    qh, kh, vh = q.reshape(shp), k.reshape(shp), v.reshape(shp)
    outs, lses = [], []
    for window, dilation in DILATED_PATTERNS:
        o, lse = _dilated_window(qh, kh, vh, window, dilation)
        outs.append(o)
        lses.append(lse)
    weights = jax.nn.softmax(jnp.stack(lses), axis=0)
    out = jnp.einsum('pbsh,pbshe->bshe', weights, jnp.stack(outs))
    return out.reshape(bsz, seq, ATTN_WIDTH).astype(q.dtype)


def _peer(h, wq, subkeys, u_tab, v_tab):
    bsz, seq, d = h.shape
    f32 = jnp.float32
    q = (h @ wq).astype(f32).reshape(bsz, seq, PEER_HEADS, 2, PEER_DQ // 2)
    sk = subkeys.astype(f32)
    s1 = jnp.einsum('bshe,ke->bshk', q[..., 0, :], sk[0])
    s2 = jnp.einsum('bshe,ke->bshk', q[..., 1, :], sk[1])
    v1, i1 = lax.top_k(s1, PEER_TOPK)
    v2, i2 = lax.top_k(s2, PEER_TOPK)
    cand = (v1[..., :, None] + v2[..., None, :]).reshape(
        bsz, seq, PEER_HEADS, PEER_TOPK * PEER_TOPK)
    top_s, top_pos = lax.top_k(cand, PEER_TOPK)
    e1 = jnp.take_along_axis(i1, top_pos // PEER_TOPK, axis=-1)
    e2 = jnp.take_along_axis(i2, top_pos % PEER_TOPK, axis=-1)
    idx = e1 * PEER_NKEYS + e2
    gate = jax.nn.softmax(top_s, axis=-1)
    n_tok = bsz * seq
    n_chunk = n_tok // PEER_CHUNK
    xs = h.reshape(n_chunk, PEER_CHUNK, d)
    ids = idx.reshape(n_chunk, PEER_CHUNK, PEER_HEADS, PEER_TOPK)
    gs = gate.reshape(n_chunk, PEER_CHUNK, PEER_HEADS, PEER_TOPK)

    def chunk(args):
        xc, ic, gc = args
        u_sel = jnp.take(u_tab, ic, axis=0)
        act = jax.nn.gelu(jnp.einsum('thkd,td->thk', u_sel, xc).astype(f32), approximate=False)
        v_sel = jnp.take(v_tab, ic, axis=0)
        return jnp.einsum('thk,thkd->td', (gc * act).astype(v_tab.dtype), v_sel)

    out = lax.map(chunk, (xs, ids, gs))
    return out.reshape(bsz, seq, d).astype(h.dtype)


def setup_inputs(seed: int = 0) -> dict:
    key = jax.random.key(seed)
    ks = jax.random.split(key, 26)
    f32 = jnp.float32

    def nrm(k, shape, scale):
        return jax.random.normal(k, shape, f32) * scale

    L, D = DEPTH, D_MODEL
    G, P, C = SSM_GROUPS, SSM_STATE, SSM_GROUP
    n_idx = jnp.arange(P, dtype=f32)
    return {
        'x': nrm(ks[0], (BATCH, SEQ, D), 1.0),
        'c': nrm(ks[1], (BATCH, D), 1.0),
        'w_ada': nrm(ks[2], (L, D, N_MOD * D), 0.5 * D ** -0.5),
        'b_ada': nrm(ks[3], (L, N_MOD * D), 0.02),
        'norm_mix': 1.0 + nrm(ks[4], (L, D), 0.02),
        'norm_ffn': 1.0 + nrm(ks[5], (L, D), 0.02),
        'w_in': nrm(ks[6], (L, D, IN_COLS), D ** -0.5),
        'ssm_lambda_re': -0.5 + nrm(ks[7], (L, G, P), 0.01),
        'ssm_lambda_im': jnp.pi * n_idx + nrm(ks[8], (L, G, P), 0.01),
        'ssm_log_dt': jax.random.uniform(ks[9], (L, G), f32, math.log(1e-3), math.log(1e-1)),
        'ssm_b_re': nrm(ks[10], (L, G, P, C), (2 * C) ** -0.5),
        'ssm_b_im': nrm(ks[11], (L, G, P, C), (2 * C) ** -0.5),
        'ssm_c_re': nrm(ks[12], (L, G, C, P), (2 * P) ** -0.5),
        'ssm_c_im': nrm(ks[13], (L, G, C, P), (2 * P) ** -0.5),
        'ssm_d': nrm(ks[14], (L, SSM_WIDTH), 1.0),
        'w_glu': nrm(ks[15], (L, SSM_WIDTH, SSM_WIDTH), SSM_WIDTH ** -0.5),
        'w_br_ssm': nrm(ks[16], (L, SSM_WIDTH, D), SSM_WIDTH ** -0.5),
        'w_br_attn': nrm(ks[17], (L, ATTN_WIDTH, D), ATTN_WIDTH ** -0.5),
        'w_out': nrm(ks[18], (L, D, D), D ** -0.5),
        'peer_wq': nrm(ks[19], (L, D, PEER_HEADS * PEER_DQ), D ** -0.5),
        'peer_subkeys': nrm(ks[20], (L, 2, PEER_NKEYS, PEER_DQ // 2), (PEER_DQ // 2) ** -0.5),
        'peer_u': nrm(ks[21], (L, PEER_EXPERTS, D), D ** -0.5),
        'peer_v': nrm(ks[22], (L, PEER_EXPERTS, D), PEER_HEADS ** -0.5),
        'norm_final': 1.0 + nrm(ks[23], (D,), 0.02),
    }


def reference(x, c, w_ada, b_ada, norm_mix, norm_ffn, w_in, ssm_lambda_re, ssm_lambda_im,
              ssm_log_dt, ssm_b_re, ssm_b_im, ssm_c_re, ssm_c_im, ssm_d, w_glu, w_br_ssm,
              w_br_attn, w_out, peer_wq, peer_subkeys, peer_u, peer_v, norm_final):
    c_act = jax.nn.silu(c)
    for l in range(DEPTH):
        mod = (c_act @ w_ada[l] + b_ada[l])[:, None, :]
        sh_m, sc_m, g_m, sh_f, sc_f, g_f = jnp.split(mod, N_MOD, axis=-1)
        h = _rmsnorm(x, norm_mix[l]) * (1.0 + sc_m) + sh_m
        z = h @ w_in[l]
        u_ssm, q, k, v, gate_s, gate_a = jnp.split(z, IN_SPLITS, axis=-1)
        y_s = _s5_branch(u_ssm, ssm_lambda_re[l], ssm_lambda_im[l], ssm_log_dt[l],
                         ssm_b_re[l], ssm_b_im[l], ssm_c_re[l], ssm_c_im[l], ssm_d[l], w_glu[l])
        y_a = _dilated_attention(q, k, v)
        merged = (jax.nn.sigmoid(gate_s) * (y_s @ w_br_ssm[l])
                  + jax.nn.sigmoid(gate_a) * (y_a @ w_br_attn[l]))
        x = x + g_m * (merged @ w_out[l])
        h = _rmsnorm(x, norm_ffn[l]) * (1.0 + sc_f) + sh_f
        x = x + g_f * _peer(h, peer_wq[l], peer_subkeys[l], peer_u[l], peer_v[l])
    return _rmsnorm(x, norm_final)
```

```cpp
#include <hip/hip_runtime.h>
#include <cstdio>
#include <cstdint>
#include <type_traits>
#define MK_PER_PHASE 0
namespace pg8 {
#define PG8_LAS __attribute__((address_space(3)))
typedef unsigned short bf16_t;
typedef short bf16x8 __attribute__((ext_vector_type(8)));
typedef float f32x4 __attribute__((ext_vector_type(4)));
typedef unsigned u32x4 __attribute__((ext_vector_type(4)));
constexpr int BM = 256, BK = 64, HALF = 128, HTB = HALF * BK * 2  , STAGE_BYTES = 8 * HTB, NXCD = 8, WGM = 8;

__host__ __device__ __forceinline__ int lds_byte(int r, int c) { const int st = (r >> 4) * 2 + (c >> 5), rr = r & 15, cc = c & 31, ob = rr * 64 + cc * 2; return st * 1024 + (ob ^ (((ob >> 9) & 1) << 5)); }
__host__ __device__ __forceinline__ void stage_rc(int b, int& R, int& C) { const int st = b / 1024, sb = b % 1024, swz = sb ^ (((sb >> 9) & 1) << 5); R = (st >> 1) * 16 + swz / 64; C = (st & 1) * 32 + (swz % 64) / 2; }
__host__ __device__ __forceinline__ int perm32(int rho) { const int n = rho >> 4, i = rho & 15; return 8 * (i >> 2) + 4 * n + (i & 3); }

struct Unit { int pm, pn; };
struct Gemm { const bf16_t* A; const bf16_t* Bt; int M, N, K; };

struct StaticOrder {
    int nM, nN, nwg, G, c;
    __host__ __device__ void init(int M, int N, int G_, int c_) { nM = M / BM; nN = N / BM; nwg = nM * nN; G = G_; c = c_; }
    __host__ __device__ bool next(int i, Unit& u) const {
        const long L = (long)i * G + c; if (L >= nwg) return false;
        int wgid = (int)L; { const int q = nwg / NXCD, r = nwg % NXCD, xcd = wgid % NXCD, off = wgid / NXCD; wgid = (xcd < r ? xcd * (q + 1) : r * (q + 1) + (xcd - r) * q) + off; }
        const int nig = WGM * nN, gid = wgid / nig, fm = gid * WGM, gsz = (nM - fm) < WGM ? (nM - fm) : WGM;
        u.pm = fm + ((wgid % nig) % gsz); u.pn = (wgid % nig) / gsz; return true;
    }
    __device__ __forceinline__ void a_ready(const Unit&) const {}
    __device__ __forceinline__ void done(const Unit&) const {}
};

__device__ __forceinline__ unsigned cvt_pk_bf16(float lo, float hi) { unsigned r; asm volatile("v_cvt_pk_bf16_f32 %0, %1, %2" : "=v"(r) : "v"(lo), "v"(hi)); return r; }
typedef float f32x2 __attribute__((ext_vector_type(2)));
__device__ __forceinline__ f32x2 gelu_pk(f32x2 v) {
    const f32x2 av = __builtin_elementwise_abs(v), d = av * 0.2316418882f + 1.0f;
    f32x2 t; t.x = __builtin_amdgcn_rcpf(d.x); t.y = __builtin_amdgcn_rcpf(d.y);
    f32x2 q = t * 0.5307027145f + (-0.7265760135f); q = q * t + 0.7107068705f; q = q * t + (-0.142248368f); q = q * t + 0.127414796f; q = q * t;
    const f32x2 s = (v * v) * (-0.72134752044f);
    f32x2 e; e.x = __builtin_amdgcn_exp2f(s.x); e.y = __builtin_amdgcn_exp2f(s.y);
    const f32x2 m = v * (q * e), r = v - m;
    f32x2 o; o.x = v.x < 0.f ? m.x : r.x; o.y = v.y < 0.f ? m.y : r.y; return o;
}
#ifndef EPI_NT
#define EPI_NT 0
#endif
#if EPI_NT
#define EPI_ST(p, v) __builtin_nontemporal_store((v), (p))
#else
#define EPI_ST(p, v) (*(p) = (v))
#endif
#ifndef EPI_NT_LD
#define EPI_NT_LD 0
#endif
#if EPI_NT_LD
#define EPI_LD(p) __builtin_nontemporal_load(p)
#else
#define EPI_LD(p) (*(p))
#endif
#ifndef UGM
#define UGM 1
#endif
#ifndef EPI_BI_RES_BF
#define EPI_BI_RES_BF 4
#define EPI_BI_RES_F32 4
#endif
#ifndef EPI_BI
#define EPI_BI(MODE) ((MODE) == 2 ? 4 : (MODE) == 1 ? 16 : 8)
#endif
#ifndef YGM
#define YGM 1
#endif
#ifndef GATE_U8
#define GATE_U8 1
#endif
__device__ __forceinline__ float sigm(float x) { return __builtin_amdgcn_rcpf(1.0f + __builtin_amdgcn_exp2f(-1.4426950408889634f * x)); }
__device__ __forceinline__ float bf_lo(unsigned u) { return __uint_as_float(u << 16); }
__device__ __forceinline__ float bf_hi(unsigned u) { return __uint_as_float(u & 0xffff0000u); }
__device__ __forceinline__ void pk8_fp8(const float (&o)[8], float q, unsigned& w0, unsigned& w1) {
    float c[8];
#pragma unroll
    for (int j = 0; j < 8; ++j) c[j] = __builtin_fminf(__builtin_fmaxf(o[j] * q, -440.0f), 440.0f);
    int a = __builtin_amdgcn_cvt_pk_fp8_f32(c[0], c[1], 0, false); a = __builtin_amdgcn_cvt_pk_fp8_f32(c[2], c[3], a, true);
    int b = __builtin_amdgcn_cvt_pk_fp8_f32(c[4], c[5], 0, false); b = __builtin_amdgcn_cvt_pk_fp8_f32(c[6], c[7], b, true); w0 = (unsigned)a; w1 = (unsigned)b;
}
struct EpiZ {
    static constexpr bool PERM = true, AFTER_DRAIN = false;
    bf16_t* O; int ldc; int sig_from; const float* rs; float cs; size_t split4; bf16_t* G; int iacc; const float* csv; int ugm;
    __device__ __forceinline__ void operator()(const f32x4 (&acc)[2][2][4][2], const Unit& u, int wr, int wc, int fr, int fq) const {
        const int row0 = u.pm * BM + wr * 64 + fr; const bool sg = u.pn >= sig_from;
        f32x4 cv[2][2];
#pragma unroll
        for (int bj = 0; bj < 2; ++bj)
#pragma unroll
            for (int n = 0; n < 2; ++n) cv[bj][n] = csv ? *(const f32x4*)(csv + u.pn * BM + wc * 32 + 8 * fq + bj * HALF + 4 * n) : (f32x4){1.f, 1.f, 1.f, 1.f};
        bf16_t* base = O; int ld = ldc, colt = u.pn * BM;
        if (split4) { if (u.pn < 16) { base = O + (size_t)(u.pn >> 2) * split4; ld = 1024; colt = (u.pn & 3) * BM; } else { base = G; ld = 4096; colt = (u.pn - 16) * BM; } }
        const int col0 = colt + wc * 32 + 8 * fq;
#pragma unroll
        for (int ai = 0; ai < 2; ++ai)
#pragma unroll
            for (int m = 0; m < 4; ++m) { const int r = row0 + ai * HALF + m * 16; bf16_t* rowp = base + (size_t)r * ld + col0; const float sc = rs ? rs[r] * cs : 1.0f;
#pragma unroll
                for (int bj = 0; bj < 2; ++bj) { f32x4 v0 = acc[ai][bj][m][0], v1 = acc[ai][bj][m][1];
                    if (iacc) {
#pragma unroll
                        for (int j = 0; j < 4; ++j) { v0[j] = (float)__float_as_int(v0[j]); v1[j] = (float)__float_as_int(v1[j]); } }
#if GATE_U8
                    if (split4 && sg) {
                        const float scn = sc * -1.4426950408889634f; v0 *= scn; v1 *= scn; if (csv) { v0 *= cv[bj][0]; v1 *= cv[bj][1]; }
                        unsigned w0 = 0u, w1 = 0u;
#pragma unroll
                        for (int j = 0; j < 4; ++j) { const float g0 = __builtin_amdgcn_rcpf(__builtin_fmaf(__builtin_amdgcn_exp2f(v0[j]), 1.0f / 255.0f, 1.0f / 255.0f)), g1 = __builtin_amdgcn_rcpf(__builtin_fmaf(__builtin_amdgcn_exp2f(v1[j]), 1.0f / 255.0f, 1.0f / 255.0f));
                            w0 = __builtin_amdgcn_cvt_pk_u8_f32(g0, j, w0); w1 = __builtin_amdgcn_cvt_pk_u8_f32(g1, j, w1); }
                        typedef unsigned u32x2_ __attribute__((ext_vector_type(2)));
                        EPI_ST((u32x2_*)((unsigned char*)G + (size_t)r * 4096 + col0 + bj * HALF), ((u32x2_){w0, w1})); continue; }
#endif
                    v0 *= sc; v1 *= sc; if (csv) { v0 *= cv[bj][0]; v1 *= cv[bj][1]; }
                    if (sg) {
#pragma unroll
                        for (int j = 0; j < 4; ++j) { v0[j] = sigm(v0[j]); v1[j] = sigm(v1[j]); } }
                    u32x4 w; w.x = cvt_pk_bf16(v0[0], v0[1]); w.y = cvt_pk_bf16(v0[2], v0[3]); w.z = cvt_pk_bf16(v1[0], v1[1]); w.w = cvt_pk_bf16(v1[2], v1[3]);
                    if (ugm && split4 && u.pn < 4) { const int c_ = col0 + bj * HALF; EPI_ST((u32x4*)(O + ((size_t)(c_ >> 4) * ugm + r) * 16 + (c_ & 15)), w); }
                    else EPI_ST((u32x4*)(rowp + bj * HALF), w); } }
    }
};
template <int MODE> struct EpiMul {
    static constexpr bool PERM = true, AFTER_DRAIN = false;
    bf16_t* O; int ldc; const bf16_t* Y; int ldy; int gcol; float cs; unsigned char* O8; float oq; const float* csv;
    typedef unsigned u32x2_ __attribute__((ext_vector_type(2)));
    struct Ld { u32x4 yv; u32x2_ yb; u32x4 pv; };
    __device__ __forceinline__ void load(Ld& x, int it, int row0, int col0) const {
        const int ai = it >> 3, m = (it >> 1) & 3, bj = it & 1; const size_t r = (size_t)(row0 + ai * HALF + m * 16);
#if GATE_U8
        if (MODE != 0) x.yb = EPI_LD((const u32x2_*)((const unsigned char*)Y + r * ldy + gcol + col0 + bj * HALF));
        else
#endif
        { const int cy_ = gcol + col0 + bj * HALF;
          x.yv = (YGM && MODE == 0) ? EPI_LD((const u32x4*)(Y + ((size_t)(cy_ >> 4) * ldy + r) * 16 + (cy_ & 15))) : EPI_LD((const u32x4*)(Y + r * ldy + cy_)); }
        if (MODE == 2) x.pv = EPI_LD((const u32x4*)(O + r * ldc + col0 + bj * HALF));
    }
    __device__ __forceinline__ void work(const Ld& x, int it, const f32x4 (&acc)[2][2][4][2], const f32x4 (&cv)[2][2], int row0, int col0) const {
        const int ai = it >> 3, m = (it >> 1) & 3, bj = it & 1; const size_t r = (size_t)(row0 + ai * HALF + m * 16);
        const f32x4 v0 = acc[ai][bj][m][0], v1 = acc[ai][bj][m][1];
        float y[8];
#if GATE_U8
        if (MODE != 0) { y[0] = (float)(x.yb.x & 255u); y[1] = (float)((x.yb.x >> 8) & 255u); y[2] = (float)((x.yb.x >> 16) & 255u); y[3] = (float)(x.yb.x >> 24);
            y[4] = (float)(x.yb.y & 255u); y[5] = (float)((x.yb.y >> 8) & 255u); y[6] = (float)((x.yb.y >> 16) & 255u); y[7] = (float)(x.yb.y >> 24); }
        else
#endif
        { y[0] = bf_lo(x.yv.x); y[1] = bf_hi(x.yv.x); y[2] = bf_lo(x.yv.y); y[3] = bf_hi(x.yv.y); y[4] = bf_lo(x.yv.z); y[5] = bf_hi(x.yv.z); y[6] = bf_lo(x.yv.w); y[7] = bf_hi(x.yv.w); }
        float o[8];
        if (MODE == 0) {
#pragma unroll
            for (int j = 0; j < 4; ++j) { o[j] = y[j] * sigm(v0[j]); o[4 + j] = y[4 + j] * sigm(v1[j]); } }
        else {
#pragma unroll
            for (int j = 0; j < 4; ++j) { o[j] = y[j] * (v0[j] * cv[bj][0][j]); o[4 + j] = y[4 + j] * (v1[j] * cv[bj][1][j]); }
            if (MODE == 2) { o[0] += bf_lo(x.pv.x); o[1] += bf_hi(x.pv.x); o[2] += bf_lo(x.pv.y); o[3] += bf_hi(x.pv.y); o[4] += bf_lo(x.pv.z); o[5] += bf_hi(x.pv.z); o[6] += bf_lo(x.pv.w); o[7] += bf_hi(x.pv.w); } }
        if (MODE == 1) { u32x4 w; w.x = cvt_pk_bf16(o[0], o[1]); w.y = cvt_pk_bf16(o[2], o[3]); w.z = cvt_pk_bf16(o[4], o[5]); w.w = cvt_pk_bf16(o[6], o[7]);
            EPI_ST((u32x4*)(O + r * ldc + col0 + bj * HALF), w); }
        else { unsigned w0, w1; pk8_fp8(o, oq, w0, w1); EPI_ST((u32x2_*)(O8 + r * ldc + col0 + bj * HALF), ((u32x2_){w0, w1})); }
    }
    __device__ __forceinline__ void operator()(const f32x4 (&acc)[2][2][4][2], const Unit& u, int wr, int wc, int fr, int fq) const {
        const int row0 = u.pm * BM + wr * 64 + fr, col0 = u.pn * BM + wc * 32 + 8 * fq;
        f32x4 cv[2][2];
        if (MODE != 0) {
#pragma unroll
            for (int bj = 0; bj < 2; ++bj)
#pragma unroll
                for (int n = 0; n < 2; ++n) cv[bj][n] = *(const f32x4*)(csv + col0 + bj * HALF + 4 * n) * cs; }
        constexpr int BI = EPI_BI(MODE), NBLK = 16 / BI;
        Ld ld[2][BI];
#pragma unroll
        for (int i = 0; i < BI; ++i) load(ld[0][i], i, row0, col0);
#pragma unroll
        for (int b = 0; b < NBLK; ++b) {
            if (b + 1 < NBLK) {
#pragma unroll
                for (int i = 0; i < BI; ++i) load(ld[(b + 1) & 1][i], (b + 1) * BI + i, row0, col0); }
            asm volatile("" ::: "memory");
#pragma unroll
            for (int i = 0; i < BI; ++i) work(ld[b & 1][i], b * BI + i, acc, cv, row0, col0);
            asm volatile("" ::: "memory"); }
    }
};
template <bool BF> struct EpiRes {
    static constexpr bool PERM = true, AFTER_DRAIN = false;
    const void* base; bf16_t* out; int ldc; const float* gate; int gate_bstride; int rows_per_batch; float cs; const float* csv;
    struct Ld { u32x4 pv; f32x4 b0, b1; };
    __device__ __forceinline__ void load(Ld& x, int it, int row0, int col0) const {
        const int ai = it >> 3, m = (it >> 1) & 3, bj = it & 1; const size_t off = (size_t)(row0 + ai * HALF + m * 16) * ldc + col0;
        if (BF) x.pv = EPI_LD((const u32x4*)((const bf16_t*)base + off + bj * HALF));
        else { x.b0 = EPI_LD((const f32x4*)((const float*)base + off + bj * HALF)); x.b1 = EPI_LD((const f32x4*)((const float*)base + off + bj * HALF + 4)); }
    }
    __device__ __forceinline__ void work(const Ld& x, int it, const f32x4 (&acc)[2][2][4][2], const f32x4 (&gv)[2][2], int row0, int col0) const {
        const int ai = it >> 3, m = (it >> 1) & 3, bj = it & 1; const size_t off = (size_t)(row0 + ai * HALF + m * 16) * ldc + col0;
        f32x4 b0, b1;
        if (BF) { b0 = (f32x4){bf_lo(x.pv.x), bf_hi(x.pv.x), bf_lo(x.pv.y), bf_hi(x.pv.y)}; b1 = (f32x4){bf_lo(x.pv.z), bf_hi(x.pv.z), bf_lo(x.pv.w), bf_hi(x.pv.w)}; } else { b0 = x.b0; b1 = x.b1; }
        const f32x4 o0 = b0 + gv[bj][0] * acc[ai][bj][m][0], o1 = b1 + gv[bj][1] * acc[ai][bj][m][1];
        u32x4 w; w.x = cvt_pk_bf16(o0[0], o0[1]); w.y = cvt_pk_bf16(o0[2], o0[3]); w.z = cvt_pk_bf16(o1[0], o1[1]); w.w = cvt_pk_bf16(o1[2], o1[3]);
        EPI_ST((u32x4*)(out + off + bj * HALF), w);
    }
    __device__ __forceinline__ void operator()(const f32x4 (&acc)[2][2][4][2], const Unit& u, int wr, int wc, int fr, int fq) const {
        const int row0 = u.pm * BM + wr * 64 + fr, col0 = u.pn * BM + wc * 32 + 8 * fq;
        const float* gp = gate + (size_t)((u.pm * BM) / rows_per_batch) * gate_bstride + col0;
        f32x4 gv[2][2];
#pragma unroll
        for (int bj = 0; bj < 2; ++bj)
#pragma unroll
            for (int n = 0; n < 2; ++n) gv[bj][n] = *(const f32x4*)(gp + bj * HALF + 4 * n) * (*(const f32x4*)(csv + col0 + bj * HALF + 4 * n) * cs);
        constexpr int BI = BF ? EPI_BI_RES_BF : EPI_BI_RES_F32, NBLK = 16 / BI;
        Ld ld[2][BI];
#pragma unroll
        for (int i = 0; i < BI; ++i) load(ld[0][i], i, row0, col0);
#pragma unroll
        for (int b = 0; b < NBLK; ++b) {
            if (b + 1 < NBLK) {
#pragma unroll
                for (int i = 0; i < BI; ++i) load(ld[(b + 1) & 1][i], (b + 1) * BI + i, row0, col0); }
            asm volatile("" ::: "memory");
#pragma unroll
            for (int i = 0; i < BI; ++i) work(ld[b & 1][i], b * BI + i, acc, gv, row0, col0);
            asm volatile("" ::: "memory"); }
    }
};

struct EpiNull {
    static constexpr bool PERM = true, AFTER_DRAIN = false;
    float* O;
    __device__ __forceinline__ void operator()(const f32x4 (&acc)[2][2][4][2], const Unit& u, int wr, int wc, int fr, int fq) const {
        float s = 0.f;
#pragma unroll
        for (int ai = 0; ai < 2; ++ai)
#pragma unroll
            for (int bj = 0; bj < 2; ++bj)
#pragma unroll
                for (int m = 0; m < 4; ++m)
#pragma unroll
                    for (int n = 0; n < 2; ++n) s += acc[ai][bj][m][n][0];
        O[(size_t)(u.pm * 8 + u.pn) * 512 + (wr * 4 + wc) * 64 + fr + 16 * fq] = s;
    }
};
template <class Epi, class Sched, bool ALIGN_EPI = false, bool SP2 = false, int QM = 0, bool AGM = false>
__device__ __forceinline__ void gemm_phase(PG8_LAS unsigned char* lds, const Gemm g, const Sched& S, const Epi& E, const int tid) {
    const int wid = __builtin_amdgcn_readfirstlane(tid >> 6), lane = tid & 63, wr = wid >> 2, wc = wid & 3, fr = lane & 15, fq = lane >> 4;
    constexpr bool F8 = (QM == 1); constexpr int ESZ = QM ? 1 : 2;
    const int K = g.K, nt = K * ESZ / (BK * 2);
    unsigned voffA[2], voffB[2];
#pragma unroll
    for (int i = 0; i < 2; ++i) { int R, C; stage_rc(tid * 16 + i * 8192, R, C); const int Rb = Epi::PERM ? ((R & ~31) + perm32(R & 31)) : R;
        voffA[i] = AGM ? (unsigned)((C >> 4) * (g.M * 32) + R * 32 + (C & 8) * 2) : (unsigned)(R * K * ESZ + C * 2); voffB[i] = (unsigned)(Rb * K * ESZ + C * 2); }
    const size_t kstep = (size_t)(BK * 2);
    const size_t hstep = (size_t)HALF * K * ESZ;
    const size_t tstep = 2 * hstep;
    const size_t kstepA = AGM ? (size_t)(BK / 16) * g.M * 32 : kstep, hstepA = AGM ? (size_t)HALF * 32 : hstep, tstepA = 2 * hstepA;
    const unsigned ldsw = (unsigned)wid * 1024u;
    const int aoff = lds_byte(wr * 64 + fr, fq * 8), boff = lds_byte(wc * 32 + fr, fq * 8);
#define PG8_SA(b, h) (((b) * 2 + (h)) * HTB)
#define PG8_SB(b, h) ((4 + (b) * 2 + (h)) * HTB)
#define PG8_STAGE(bufoff, gbase, voff) do { _Pragma("unroll") for (int _i = 0; _i < 2; ++_i) \
        __builtin_amdgcn_global_load_lds((const unsigned*)((const char*)(gbase) + (voff)[_i]), (PG8_LAS unsigned*)(lds + (bufoff) + ldsw + _i * 8192), 16, 0, 0); } while (0)
#define PG8_LDA(dst, b, h) do { _Pragma("unroll") for (int m = 0; m < 4; ++m) { if constexpr (F8) { const v4i_ lo_ = *(const PG8_LAS v4i_*)(lds + PG8_SA(b, h) + aoff + m * 2048), hi_ = *(const PG8_LAS v4i_*)(lds + PG8_SA(b, h) + aoff + m * 2048 + 1024); \
            dst[m][0] = __builtin_bit_cast(frag_t, __builtin_shufflevector(lo_, hi_, 0, 1, 2, 3, 4, 5, 6, 7)); } \
        else { _Pragma("unroll") for (int k = 0; k < 2; ++k) dst[m][k] = __builtin_bit_cast(frag_t, *(const PG8_LAS bf16x8*)(lds + PG8_SA(b, h) + aoff + m * 2048 + k * 1024)); } } } while (0)
#define PG8_LDB(dst, b, h) do { _Pragma("unroll") for (int n = 0; n < 2; ++n) { if constexpr (F8) { const v4i_ lo_ = *(const PG8_LAS v4i_*)(lds + PG8_SB(b, h) + boff + n * 2048), hi_ = *(const PG8_LAS v4i_*)(lds + PG8_SB(b, h) + boff + n * 2048 + 1024); \
            dst[n][0] = __builtin_bit_cast(frag_t, __builtin_shufflevector(lo_, hi_, 0, 1, 2, 3, 4, 5, 6, 7)); } \
        else { _Pragma("unroll") for (int k = 0; k < 2; ++k) dst[n][k] = __builtin_bit_cast(frag_t, *(const PG8_LAS bf16x8*)(lds + PG8_SB(b, h) + boff + n * 2048 + k * 1024)); } } } while (0)
#define PG8_MMA(ai, bj, At, Bt) do { __builtin_amdgcn_s_setprio(1); \
        if constexpr (QM == 2) {   \
            _Pragma("unroll") for (int k = 0; k < 2; ++k) _Pragma("unroll") for (int m = 0; m < 4; ++m) _Pragma("unroll") for (int n = 0; n < 2; ++n) \
                asm volatile("v_mfma_i32_16x16x64_i8 %0, %1, %2, %0" : "+v"(acc[ai][bj][m][n]) : "v"(__builtin_bit_cast(bf16x8, Bt[n][k])), "v"(__builtin_bit_cast(bf16x8, At[m][k]))); } \
        else { _Pragma("unroll") for (int m = 0; m < 4; ++m) _Pragma("unroll") for (int n = 0; n < 2; ++n) { \
            if constexpr (F8) { asm volatile("v_mfma_f32_16x16x128_f8f6f4 %0, %1, %2, %0" : "+v"(acc[ai][bj][m][n]) : "v"(__builtin_bit_cast(v8i_, Bt[n][0])), "v"(__builtin_bit_cast(v8i_, At[m][0]))); }     \
            else { _Pragma("unroll") for (int k = 0; k < (F8 ? 1 : 2); ++k) acc[ai][bj][m][n] = __builtin_amdgcn_mfma_f32_16x16x32_bf16(__builtin_bit_cast(bf16x8, Bt[n][k]), __builtin_bit_cast(bf16x8, At[m][k]), acc[ai][bj][m][n], 0, 0, 0); } } } \
        __builtin_amdgcn_s_setprio(0); } while (0)
#define PG8_WAIT_V(n) asm volatile("s_waitcnt vmcnt(" #n ")" ::: "memory")
#define PG8_WAIT_L(n) asm volatile("s_waitcnt lgkmcnt(" #n ")" ::: "memory")
#define PG8_BAR __builtin_amdgcn_s_barrier()
#define PG8_SCHED __builtin_amdgcn_sched_barrier(0)
    Unit cur, nxt; int ui = 0;
    if (!S.next(0, cur)) return;
    f32x4 acc[2][2][4][2];
#pragma unroll
    for (int a = 0; a < 2; ++a)
#pragma unroll
        for (int b = 0; b < 2; ++b)
#pragma unroll
            for (int m = 0; m < 4; ++m)
#pragma unroll
                for (int n = 0; n < 2; ++n) acc[a][b][m][n] = (f32x4){0.f, 0.f, 0.f, 0.f};
    typedef int v4i_ __attribute__((ext_vector_type(4))); typedef int v8i_ __attribute__((ext_vector_type(8)));
    typedef typename std::conditional<F8, v8i_, bf16x8>::type frag_t;
    frag_t At[4][F8 ? 1 : 2], B0[2][F8 ? 1 : 2], B1[2][F8 ? 1 : 2];
    const char* cA = (const char*)g.A + (size_t)cur.pm * tstepA; const char* cB = (const char*)g.Bt + (size_t)cur.pn * tstep;
    S.a_ready(cur);
    if constexpr (SP2) {
        PG8_STAGE(PG8_SB(0, 0), cB, voffB); PG8_STAGE(PG8_SB(0, 1), cB + hstep, voffB); PG8_STAGE(PG8_SA(0, 0), cA, voffA); PG8_STAGE(PG8_SA(0, 1), cA + hstepA, voffA);
        if (wr == 1) PG8_BAR;
        PG8_WAIT_V(2); PG8_BAR;
        PG8_STAGE(PG8_SB(1, 0), cB + kstep, voffB); PG8_STAGE(PG8_SA(1, 0), cA + kstepA, voffA); PG8_STAGE(PG8_SB(1, 1), cB + hstep + kstep, voffB);
        PG8_WAIT_V(6); PG8_BAR;
    } else {
        PG8_STAGE(PG8_SB(0, 0), cB, voffB); PG8_STAGE(PG8_SA(0, 0), cA, voffA); PG8_STAGE(PG8_SB(0, 1), cB + hstep, voffB); PG8_STAGE(PG8_SA(0, 1), cA + hstepA, voffA);
        if (wr == 1) PG8_BAR;
        PG8_WAIT_V(4); PG8_BAR;
        PG8_STAGE(PG8_SB(1, 0), cB + kstep, voffB); PG8_STAGE(PG8_SA(1, 0), cA + kstepA, voffA); PG8_STAGE(PG8_SB(1, 1), cB + hstep + kstep, voffB);
        PG8_WAIT_V(6); PG8_BAR;
    }
    for (;;) {
        const bool has_next = S.next(ui + 1, nxt);
        const char* nA = has_next ? (const char*)g.A + (size_t)nxt.pm * tstepA : cA; const char* nB = has_next ? (const char*)g.Bt + (size_t)nxt.pn * tstep : cB;
        for (int t = 0; t < nt; t += 2) {
            const bool last = (t == nt - 2);
            const char* a1 = cA + (size_t)(t + 1) * kstepA;
            const char* a2 = last ? nA : cA + (size_t)(t + 2) * kstepA; const char* b2 = last ? nB : cB + (size_t)(t + 2) * kstep;
            const char* a3 = a2 + kstepA; const char* b3 = b2 + kstep;
            if (last && has_next) S.a_ready(nxt);
            if constexpr (SP2) {
            PG8_LDB(B0, 0, 0); PG8_LDB(B1, 0, 1); PG8_SCHED; PG8_LDA(At, 0, 0); PG8_STAGE(PG8_SA(1, 1), a1 + hstepA, voffA);
            PG8_WAIT_V(8); PG8_WAIT_L(0); PG8_BAR; PG8_MMA(0, 0, At, B0); PG8_MMA(0, 1, At, B1); PG8_BAR; PG8_SCHED;
            PG8_LDA(At, 0, 1); PG8_STAGE(PG8_SB(0, 0), b2, voffB); PG8_STAGE(PG8_SB(0, 1), b2 + hstep, voffB); PG8_STAGE(PG8_SA(0, 0), a2, voffA);
            PG8_WAIT_V(8); PG8_WAIT_L(0); PG8_BAR; PG8_MMA(1, 0, At, B0); PG8_MMA(1, 1, At, B1); PG8_BAR; PG8_SCHED;
            PG8_LDB(B0, 1, 0); PG8_LDB(B1, 1, 1); PG8_SCHED; PG8_LDA(At, 1, 0); PG8_STAGE(PG8_SA(0, 1), a2 + hstepA, voffA);
            PG8_WAIT_V(8); PG8_WAIT_L(0); PG8_BAR; PG8_MMA(0, 0, At, B0); PG8_MMA(0, 1, At, B1); PG8_BAR; PG8_SCHED;
            PG8_LDA(At, 1, 1); PG8_STAGE(PG8_SB(1, 0), b3, voffB); PG8_STAGE(PG8_SB(1, 1), b3 + hstep, voffB); PG8_STAGE(PG8_SA(1, 0), a3, voffA);
            PG8_WAIT_V(8); PG8_WAIT_L(0); PG8_BAR; PG8_MMA(1, 0, At, B0); PG8_MMA(1, 1, At, B1); PG8_BAR; PG8_SCHED;
            } else {
            PG8_LDB(B0, 0, 0); PG8_SCHED; PG8_LDA(At, 0, 0); PG8_STAGE(PG8_SA(1, 1), a1 + hstepA, voffA);
            PG8_WAIT_L(8); PG8_BAR; PG8_WAIT_L(0); PG8_MMA(0, 0, At, B0); PG8_BAR; PG8_SCHED;
            PG8_LDB(B1, 0, 1); PG8_STAGE(PG8_SB(0, 0), b2, voffB);
            PG8_BAR; PG8_WAIT_L(0); PG8_MMA(0, 1, At, B1); PG8_BAR;
            PG8_LDA(At, 0, 1); PG8_STAGE(PG8_SA(0, 0), a2, voffA);
            PG8_BAR; PG8_WAIT_L(0); PG8_MMA(1, 0, At, B0); PG8_BAR; PG8_SCHED;
            PG8_STAGE(PG8_SB(0, 1), b2 + hstep, voffB);
            PG8_WAIT_V(6); PG8_BAR; PG8_MMA(1, 1, At, B1); PG8_BAR;
            PG8_LDB(B0, 1, 0); PG8_SCHED; PG8_LDA(At, 1, 0); PG8_STAGE(PG8_SA(0, 1), a2 + hstepA, voffA);
            PG8_WAIT_L(8); PG8_BAR; PG8_WAIT_L(0); PG8_MMA(0, 0, At, B0); PG8_BAR; PG8_SCHED;
            PG8_LDB(B1, 1, 1); PG8_STAGE(PG8_SB(1, 0), b3, voffB);
            PG8_BAR; PG8_WAIT_L(0); PG8_MMA(0, 1, At, B1); PG8_BAR;
            PG8_LDA(At, 1, 1); PG8_STAGE(PG8_SA(1, 0), a3, voffA);
            PG8_BAR; PG8_WAIT_L(0); PG8_MMA(1, 0, At, B0); PG8_BAR; PG8_SCHED;
            PG8_STAGE(PG8_SB(1, 1), b3 + hstep, voffB);
            PG8_WAIT_V(6); PG8_BAR; PG8_MMA(1, 1, At, B1); PG8_BAR;
            }
        }
        if constexpr (ALIGN_EPI) { if (wr == 0) PG8_BAR; }
        if constexpr (!Epi::AFTER_DRAIN) { E(acc, cur, wr, wc, fr, fq); S.done(cur); }
        if (!has_next) break;
#pragma unroll
        for (int a = 0; a < 2; ++a)
#pragma unroll
            for (int b = 0; b < 2; ++b)
#pragma unroll
                for (int m = 0; m < 4; ++m)
#pragma unroll
                    for (int n = 0; n < 2; ++n) acc[a][b][m][n] = (f32x4){0.f, 0.f, 0.f, 0.f};
        cur = nxt; cA = nA; cB = nB; ++ui;
        if constexpr (ALIGN_EPI) { if (wr == 1) PG8_BAR; }
    }
    PG8_WAIT_V(0);
    if constexpr (!ALIGN_EPI) { if (wr == 0) PG8_BAR; }
    PG8_BAR;
    if constexpr (Epi::AFTER_DRAIN) { E.fused(acc, cur, wr, wc, fr, fq, lds, wid, lane); S.done(cur); }
#undef PG8_SA
#undef PG8_SB
#undef PG8_STAGE
#undef PG8_LDA
#undef PG8_LDB
#undef PG8_MMA
#undef PG8_WAIT_V
#undef PG8_WAIT_L
#undef PG8_BAR
#undef PG8_SCHED
}
}
constexpr int D = 2048, NB = 4, SEQ = 4096, M = NB * SEQ, DEPTH = 2, INC = 8192, NMOD = 6 * D;
constexpr int NE = 16384;
constexpr float EPS = 1e-6f;
constexpr int NWAVES = 8, NTHR = 512;
constexpr size_t MiB = 1u << 20;
constexpr size_t WS_CTL = 0, CTL_ZERO_BYTES = 64 * 1024;
constexpr size_t WS_MOD = 1 * MiB;
constexpr size_t WS_A16 = WS_MOD + 393216;
constexpr size_t WS_SKB = WS_A16 + 65536;
constexpr size_t WS_DS = WS_SKB + 131072;
constexpr size_t WS_WSC = WS_DS + 262144;
constexpr int WSC_L = 16384, WSC_IN = 0, WSC_BRS = 8192, WSC_BRA = 10240, WSC_OUT = 12288, WSC_WQ = 14336;
static_assert(WS_WSC + 2 * WSC_L * 4 <= 2 * MiB, "scale table overlaps the SSM tables");
#ifndef WQ_I8
#define WQ_I8 1
#endif
constexpr size_t WS_TF = 2 * MiB;
constexpr size_t WS_WF = WS_TF + 2 * MiB;
constexpr size_t WS_BF = WS_WF + 8 * MiB;
constexpr size_t WS_WIN = WS_BF + 8 * MiB;
constexpr size_t WS_WGLU = WS_WIN + 64 * MiB;
constexpr size_t WS_WBRS = WS_WGLU + 4 * MiB;
constexpr size_t WS_WBRA = WS_WBRS + 8 * MiB;
constexpr size_t WS_WOUT = WS_WBRA + 8 * MiB;
constexpr size_t WS_WQ = WS_WOUT + 16 * MiB;
constexpr size_t WS_PU = WS_WQ + 16 * MiB;
constexpr size_t WS_PV = WS_PU + 64 * MiB;
constexpr size_t WS_H = WS_PV + 64 * MiB;
constexpr size_t WS_Z = WS_H + 64 * MiB;
constexpr size_t WS_ZU = WS_Z, WS_ZQ = WS_Z + 32 * MiB, WS_ZK = WS_Z + 64 * MiB, WS_ZV = WS_Z + 96 * MiB, WS_ZG = WS_Z + 128 * MiB;
constexpr size_t WS_Y = WS_Z + 256 * MiB;
constexpr size_t WS_YS = WS_Y + 32 * MiB;
constexpr size_t WS_YA = WS_YS + 32 * MiB;
constexpr size_t WS_OB = WS_YA + 32 * MiB;
constexpr size_t WS_QP = WS_OB;
constexpr size_t WS_LSE = WS_OB + 96 * MiB;
constexpr size_t WS_MG = WS_LSE + 2 * MiB;
constexpr size_t WS_HLOC = WS_MG, WS_HPREV = WS_MG + 32 * MiB;
constexpr size_t WS_IDS = WS_MG + 64 * MiB;
constexpr size_t WS_GATE = WS_IDS + 8 * MiB;
constexpr size_t WS_IDS16 = WS_GATE + 8 * MiB;
constexpr size_t WS_IDS16T = WS_IDS16 + 4 * MiB;
constexpr size_t WS_H8 = WS_IDS16T + 4 * MiB;
constexpr size_t WS_HS = WS_H8 + 32 * MiB;
constexpr size_t WS_END = WS_HS + 1 * MiB;
constexpr size_t WS_P = WS_Z;
constexpr size_t WS_W = WS_Z + 128 * MiB;
constexpr size_t WS_HQ = WS_HS + 1 * MiB;
constexpr size_t WS_HQS = WS_HQ + 32 * MiB;
constexpr size_t WS_WQ8 = WS_HQS + 1 * MiB;
constexpr size_t WS_WS = WS_WQ8 + 2 * MiB;
constexpr size_t WS_MG8 = WS_WS + 1 * MiB;
constexpr size_t WS_XB = WS_MG8 + 32 * MiB;
constexpr size_t WS_END2 = WS_XB + 64 * MiB;
constexpr int CW_WMAX = 3600;
constexpr int CW_QPRO = 3520;
constexpr int CW_RANK = 4096;
constexpr int LDS_BYTES = 163840, MISC_OFF = LDS_BYTES - 256;

#define GAS __attribute__((address_space(1)))
#define LAS __attribute__((address_space(3)))
typedef unsigned short bf16;
typedef unsigned v4u __attribute__((ext_vector_type(4)));
typedef unsigned v2u __attribute__((ext_vector_type(2)));
typedef float f32x4 __attribute__((ext_vector_type(4)));
typedef float f32x2 __attribute__((ext_vector_type(2)));
typedef float f32x16 __attribute__((ext_vector_type(16)));
typedef short bf16x8 __attribute__((ext_vector_type(8)));
typedef short s16x4 __attribute__((ext_vector_type(4)));
typedef __bf16 bf16x2 __attribute__((ext_vector_type(2)));
#define MFMA32(a, b, c) __builtin_amdgcn_mfma_f32_32x32x16_bf16((a), (b), (c), 0, 0, 0)
#define MFMA16(a, b, c) __builtin_amdgcn_mfma_f32_16x16x32_bf16((a), (b), (c), 0, 0, 0)
using pg8::cvt_pk_bf16; using pg8::gelu_pk; using pg8::sigm; using pg8::bf_lo; using pg8::bf_hi;
__device__ __forceinline__ float wave_sum(float v) {
#pragma unroll
    for (int o = 1; o < 64; o <<= 1) v += __shfl_xor(v, o);
    return v;
}
__device__ __forceinline__ float dot2(unsigned a, unsigned b, float c) { return __builtin_amdgcn_fdot2_f32_bf16(__builtin_bit_cast(bf16x2, a), __builtin_bit_cast(bf16x2, b), c, false); }
__device__ __forceinline__ float gelu1(float v) { const f32x2 r = gelu_pk((f32x2){v, 0.f}); return r.x; }

#define XB_TMO      128
#define XB_XCNT(j)  (256  + 64 * (j))
#define XB_XSUB(j)  (1280 + 64 * (j))
#define XB_XGEN(j)  (2304 + 64 * (j))
#define XB_TOP      3328
#define XB_TOPGEN   3392
#define XCD_BAR_WORDS 3456
#define XB_SPIN_CAP (1u << 18)

__device__ __forceinline__ unsigned xb_ld(unsigned* p)              { return __hip_atomic_load(p, __ATOMIC_RELAXED, __HIP_MEMORY_SCOPE_AGENT); }
__device__ __forceinline__ unsigned xb_add(unsigned* p, unsigned v) { return __hip_atomic_fetch_add(p, v, __ATOMIC_RELAXED, __HIP_MEMORY_SCOPE_AGENT); }
__device__ __forceinline__ unsigned xb_xcc_id() { return (unsigned)__builtin_amdgcn_s_getreg((3 << 11) | 20) & 0xFu; }
#define XB_SPIN(cond, bar) do { unsigned _sp = 0; while (cond) { __builtin_amdgcn_s_sleep(1); \
    if ((++_sp & 255u) == 0u) { if (xb_ld(&(bar)[XB_TMO])) break; if (_sp > XB_SPIN_CAP) { atomicAdd(&(bar)[XB_TMO], 1u); break; } } } } while (0)

struct XcdBarrier {
    unsigned* bar; unsigned x;
    volatile LAS unsigned* st;
};

__device__ __forceinline__ XcdBarrier xcd_barrier_post(unsigned* bar, volatile LAS unsigned* st) {
    XcdBarrier b; b.bar = bar; b.x = xb_xcc_id(); b.st = st;
    if (threadIdx.x == 0) (void)xb_add(&bar[XB_XCNT(b.x)], 1u);
    return b;
}
__device__ __forceinline__ void xcd_barrier_complete(unsigned* bar, unsigned x, unsigned& nloc, unsigned& nx) {
    const unsigned G = gridDim.x * gridDim.y * gridDim.z;
    unsigned sum, cnt, mine, sp = 0u;
    for (;;) {
        sum = 0u; cnt = 0u; mine = 0u;
#pragma unroll
        for (unsigned j = 0; j < 16; ++j) { const unsigned c = xb_ld(&bar[XB_XCNT(j)]); sum += c; cnt += (c > 0u) ? 1u : 0u; mine = (j == x) ? c : mine; }
        if (sum == G) break;
        __builtin_amdgcn_s_sleep(1);
        if ((++sp & 255u) == 0u) { if (xb_ld(&bar[XB_TMO])) break; if (sp > XB_SPIN_CAP) { atomicAdd(&bar[XB_TMO], 1u); break; } }
    }
    nloc = mine > 0u ? mine : 1u; nx = cnt > 0u ? cnt : 1u;
}

__device__ __forceinline__ void xcd_barrier(const XcdBarrier& b) {
    asm volatile("s_waitcnt vmcnt(0)" ::: "memory");
    __syncthreads();
    if (threadIdx.x == 0) {
        unsigned* bar = b.bar;
        __builtin_amdgcn_s_waitcnt(0);
        unsigned nloc = b.st[0], nx = b.st[1];
        if (nloc == 0u) { xcd_barrier_complete(bar, b.x, nloc, nx); b.st[0] = nloc; b.st[1] = nx; }
        const unsigned old = xb_add(&bar[XB_XSUB(b.x)], 1u);
        const unsigned gen = old / nloc;
        if (old + 1u == (gen + 1u) * nloc) {
            __builtin_amdgcn_fence(__ATOMIC_RELEASE, "agent");
            asm volatile("s_waitcnt vmcnt(0)" ::: "memory");
            const unsigned og = xb_add(&bar[XB_TOP], 1u);
            const unsigned tg = og / nx;
            if (og + 1u == (tg + 1u) * nx) xb_add(&bar[XB_TOPGEN], 1u);
            else XB_SPIN(xb_ld(&bar[XB_TOPGEN]) == tg, bar);
            __builtin_amdgcn_fence(__ATOMIC_ACQUIRE, "agent");
            xb_add(&bar[XB_XGEN(b.x)], 1u);
            asm volatile("s_waitcnt vmcnt(0)" ::: "memory");
        } else {
            XB_SPIN(xb_ld(&bar[XB_XGEN(b.x)]) == gen, bar);
            __builtin_amdgcn_fence(__ATOMIC_ACQUIRE, "agent");
            asm volatile("s_waitcnt vmcnt(0)" ::: "memory");
        }
    }
    __syncthreads();
}

#ifndef SSM_LDS_STATE
#define SSM_LDS_STATE 1
#endif
#ifndef PEER_DEFER
#define PEER_DEFER 1
#endif
#ifndef WCOL
#define WCOL 1
#endif
struct Args { const float* in[24]; float* out; unsigned char* ws; int ph_lo, ph_hi; };

__device__ __forceinline__ void p0_transpose_item(const float* W, int K, int N, bf16* WT, LAS float* scr, int item, int lane) {
    const int nblk = N / 32, kb = item / nblk, nb = item % nblk, k0 = 64 * kb, n0 = 32 * nb;
#pragma unroll 8
    for (int i = 0; i < 32; ++i) { const int kk = 2 * i + (lane >> 5); scr[kk * 33 + (lane & 31)] = W[(size_t)(k0 + kk) * N + n0 + (lane & 31)]; }
    asm volatile("s_waitcnt lgkmcnt(0)" ::: "memory");
    const int c = lane & 7;
#pragma unroll
    for (int j = 0; j < 4; ++j) { const int n = (lane >> 3) + 8 * j; const LAS float* s = scr + (8 * c) * 33 + n;
        v4u o; o.x = cvt_pk_bf16(s[0 * 33], s[1 * 33]); o.y = cvt_pk_bf16(s[2 * 33], s[3 * 33]); o.z = cvt_pk_bf16(s[4 * 33], s[5 * 33]); o.w = cvt_pk_bf16(s[6 * 33], s[7 * 33]);
        *(v4u*)(WT + (size_t)(n0 + n) * K + k0 + 8 * c) = o; }
    asm volatile("s_waitcnt lgkmcnt(0)" ::: "memory");
}
__device__ __forceinline__ void cvt8(const float* src, bf16* dst, size_t i8) {
    const f32x4 a = *(const f32x4*)(src + i8 * 8), b = *(const f32x4*)(src + i8 * 8 + 4);
    v4u o; o.x = cvt_pk_bf16(a[0], a[1]); o.y = cvt_pk_bf16(a[2], a[3]); o.z = cvt_pk_bf16(b[0], b[1]); o.w = cvt_pk_bf16(b[2], b[3]);
    *(v4u*)(dst + i8 * 8) = o;
}
__device__ __forceinline__ unsigned pack_i8(float a, float b, float c, float d) {
    const int ia = (int)rintf(a), ib = (int)rintf(b), ic = (int)rintf(c), id = (int)rintf(d);
    return ((unsigned)ia & 255u) | (((unsigned)ib & 255u) << 8) | (((unsigned)ic & 255u) << 16) | ((unsigned)id << 24);
}
__device__ __forceinline__ void ssm_tables_item(const Args& a, LAS unsigned char* lds, int l, int g, int tid) {
    LAS float* apow = (LAS float*)(lds); LAS float* bbar = (LAS float*)(lds + 8704); LAS float* cm = (LAS float*)(lds + 16896); LAS float* Km = (LAS float*)(lds + 25088);
    const int lg = l * 64 + g;
    if (tid < 64) {
        const int p = tid;
        const float dt = expf(a.in[9][lg]); const float lr = a.in[7][lg * 64 + p], li = a.in[8][lg * 64 + p];
        for (int k = 0; k <= 16; ++k) { const float mg = expf(lr * dt * (float)k), ang = li * dt * (float)k; apow[(k * 64 + p) * 2] = mg * cosf(ang); apow[(k * 64 + p) * 2 + 1] = mg * sinf(ang); }
        const float mg1 = expf(lr * dt), ar = mg1 * cosf(li * dt), ai = mg1 * sinf(li * dt);
        const float inv = 1.0f / (lr * lr + li * li);
        const float cr = ((ar - 1.0f) * lr + ai * li) * inv, ci = (ai * lr - (ar - 1.0f) * li) * inv;
        for (int c = 0; c < 16; ++c) { const float br = a.in[10][(size_t)(lg * 64 + p) * 16 + c], bi = a.in[11][(size_t)(lg * 64 + p) * 16 + c];
            bbar[(p * 16 + c) * 2] = cr * br - ci * bi; bbar[(p * 16 + c) * 2 + 1] = cr * bi + ci * br; }
        float* A16 = (float*)(a.ws + WS_A16);
        { const float mg = expf(lr * dt * 16.0f), ang = li * dt * 16.0f; A16[(lg * 64 + p) * 2] = mg * cosf(ang); A16[(lg * 64 + p) * 2 + 1] = mg * sinf(ang); }
    }
    for (int i = tid; i < 1024; i += NTHR) { cm[i * 2] = a.in[12][(size_t)lg * 1024 + i]; cm[i * 2 + 1] = a.in[13][(size_t)lg * 1024 + i]; }
    __syncthreads();
    for (int i = tid; i < 4096; i += NTHR) { const int tau = i >> 8, c = (i >> 4) & 15, cp = i & 15; float s = 0.f;
        for (int p = 0; p < 64; ++p) { const float cr = cm[(c * 64 + p) * 2], ci = cm[(c * 64 + p) * 2 + 1], ar = apow[(tau * 64 + p) * 2], ai = apow[(tau * 64 + p) * 2 + 1];
            const float zr = cr * ar - ci * ai, zi = cr * ai + ci * ar; s += zr * bbar[(p * 16 + cp) * 2] - zi * bbar[(p * 16 + cp) * 2 + 1]; }
        if (tau == 0 && c == cp) s += a.in[14][l * 1024 + g * 16 + c];
        Km[i] = s; }
    __syncthreads();
    bf16* TF = (bf16*)(a.ws + WS_TF) + (size_t)lg * 16 * 512;
    for (int i = tid; i < 16 * 512; i += NTHR) { const int li_ = i >> 9, ln = (i >> 3) & 63, j = i & 7, r = ln & 31, h = ln >> 5; const int tau = li_ - 1 + (r >> 4);
        const float v = (tau >= 0 && tau < 16) ? Km[(tau * 16 + (r & 15)) * 16 + 8 * h + j] : 0.f; TF[i] = (bf16)(cvt_pk_bf16(v, 0.f) & 0xffffu); }
    bf16* WF = (bf16*)(a.ws + WS_WF) + (size_t)lg * 64 * 512;
    for (int i = tid; i < 64 * 512; i += NTHR) { const int f = i >> 9, ti = f >> 3, kk = f & 7, ln = (i >> 3) & 63, j = i & 7, r = ln & 31, h = ln >> 5;
        const int t = 2 * ti + (r >> 4), c = r & 15, rho = 16 * kk + 8 * h + j, p = rho >> 1, ri = rho & 1;
        const float cr = cm[(c * 64 + p) * 2], ci = cm[(c * 64 + p) * 2 + 1], ar = apow[((t + 1) * 64 + p) * 2], ai = apow[((t + 1) * 64 + p) * 2 + 1];
        const float zr = cr * ar - ci * ai, zi = cr * ai + ci * ar; const float v = ri ? -zi : zr; WF[i] = (bf16)(cvt_pk_bf16(v, 0.f) & 0xffffu); }
    bf16* BF = (bf16*)(a.ws + WS_BF) + (size_t)lg * 64 * 512;
    for (int i = tid; i < 64 * 512; i += NTHR) { const int f = i >> 9, q = f >> 4, s = f & 15, ln = (i >> 3) & 63, j = i & 7, r = ln & 31, h = ln >> 5;
        const int rho = 32 * q + r, p = rho >> 1, ri = rho & 1, cp = 8 * h + j;
        const float ar = apow[((15 - s) * 64 + p) * 2], ai = apow[((15 - s) * 64 + p) * 2 + 1], br = bbar[(p * 16 + cp) * 2], bi = bbar[(p * 16 + cp) * 2 + 1];
        const float zr = ar * br - ai * bi, zi = ar * bi + ai * br; const float v = ri ? zi : zr; BF[i] = (bf16)(cvt_pk_bf16(v, 0.f) & 0xffffu); }
    __syncthreads();
}
__device__ __forceinline__ void win_absmax(const Args& a, int tid, int lane);
template <int KPL, bool I8> __device__ __forceinline__ void wconv_item(const float* W, int N, int n0, unsigned char* WT, float* wsc, LAS float* red, int lane, int wave) {
    constexpr int K = KPL * 16;
    const int col = lane & 31, kb = wave * (2 * KPL) + (lane >> 5) * KPL;
    const float* src = W + (size_t)kb * N + n0 + col;
    float v[KPL]; float mx = 0.f;
#pragma unroll
    for (int i = 0; i < KPL; ++i) v[i] = src[(size_t)i * N];
#pragma unroll
    for (int i = 0; i < KPL; ++i) mx = fmaxf(mx, fabsf(v[i]));
    mx = fmaxf(mx, __shfl_xor(mx, 32));
    if (lane < 32) red[wave * 32 + lane] = mx;
    __syncthreads();
    float cm = 0.f;
#pragma unroll
    for (int w = 0; w < 8; ++w) cm = fmaxf(cm, red[w * 32 + col]);
    const float top = I8 ? 127.0f : 400.0f; const float q = cm > 0.f ? top / cm : 1.0f;
    if (wave == 0 && lane < 32) wsc[n0 + col] = cm > 0.f ? cm / top : 1.0f;
    unsigned char* dst = WT + (size_t)(n0 + col) * K + kb;
#pragma unroll
    for (int j = 0; j < KPL / 16; ++j) { unsigned w[4];
#pragma unroll
        for (int e = 0; e < 4; ++e) { const float x0 = v[16 * j + 4 * e] * q, x1 = v[16 * j + 4 * e + 1] * q, x2 = v[16 * j + 4 * e + 2] * q, x3 = v[16 * j + 4 * e + 3] * q;
            if (I8) w[e] = pack_i8(x0, x1, x2, x3);
            else { int t = __builtin_amdgcn_cvt_pk_fp8_f32(x0, x1, 0, false); t = __builtin_amdgcn_cvt_pk_fp8_f32(x2, x3, t, true); w[e] = (unsigned)t; } }
        *(v4u*)(dst + 16 * j) = (v4u){w[0], w[1], w[2], w[3]}; }
    __syncthreads();
}
__device__ __forceinline__ void wconv_all(const Args& a, LAS unsigned char* lds, int lane, int wave) {
    LAS float* red = (LAS float*)lds; float* WSC = (float*)(a.ws + WS_WSC);
    for (int it = blockIdx.x; it < (WQ_I8 ? 1024 : 896); it += gridDim.x) {
        if (it >= 896) { const int j = it - 896, l = j >> 6, nb = j & 63; wconv_item<128, true>(a.in[19] + (size_t)l * D * D, D, 32 * nb, a.ws + WS_WQ + (size_t)l * D * D, WSC + l * WSC_L + WSC_WQ, red, lane, wave); }
        else if (it < 512) { const int l = it >> 8, nb = it & 255; wconv_item<128, true>(a.in[6] + (size_t)l * D * INC, INC, 32 * nb, a.ws + WS_WIN + (size_t)l * INC * D, WSC + l * WSC_L + WSC_IN, red, lane, wave); }
        else if (it >= 640 && it < 768) { const int j = it - 640, l = j >> 6, nb = j & 63; wconv_item<128, false>(a.in[18] + (size_t)l * D * D, D, 32 * nb, a.ws + WS_WOUT + (size_t)l * D * D, WSC + l * WSC_L + WSC_OUT, red, lane, wave); }
        else { const int j = it < 640 ? it - 512 : 128 + (it - 768); const int l = j >> 7, wh = (j >> 6) & 1, nb = j & 63;
            wconv_item<64, false>((wh ? a.in[17] : a.in[16]) + (size_t)l * 1024 * D, D, 32 * nb, a.ws + (wh ? WS_WBRA : WS_WBRS) + (size_t)l * D * 1024, WSC + l * WSC_L + (wh ? WSC_BRA : WSC_BRS), red, lane, wave); }
    }
}
__device__ __forceinline__ void peer_conv_row(const Args& a, int tab, int row, int lane) {
    float* DS = (float*)(a.ws + WS_DS);
    const float* src = (tab ? a.in[22] : a.in[21]) + (size_t)row * D + 4 * lane;
    f32x4 v[8]; float mx = 0.f;
#pragma unroll
    for (int j = 0; j < 8; ++j) { v[j] = *(const f32x4*)(src + 256 * j); mx = fmaxf(mx, fmaxf(fmaxf(fabsf(v[j][0]), fabsf(v[j][1])), fmaxf(fabsf(v[j][2]), fabsf(v[j][3])))); }
#pragma unroll
    for (int o = 1; o < 64; o <<= 1) mx = fmaxf(mx, __shfl_xor(mx, o));
    const float sc = mx > 0.f ? 127.0f / mx : 1.0f;
    if (lane == 0) DS[(size_t)tab * DEPTH * NE + row] = mx > 0.f ? mx * (1.0f / 127.0f) : 1.0f;
    unsigned char* dstb = (tab ? a.ws + WS_PV : a.ws + WS_PU) + (size_t)(row / NE) * NE * D + (size_t)(row % NE) * 128;
#pragma unroll
    for (int j = 0; j < 8; ++j) { const unsigned w = pack_i8(v[j][0] * sc, v[j][1] * sc, v[j][2] * sc, v[j][3] * sc);
        const int bo = 4 * (lane + 64 * j); *(unsigned*)(dstb + (size_t)(bo >> 7) * NE * 128 + (bo & 127)) = w; }
}
__device__ __forceinline__ void peer_conv_row2(const Args& a, int tab, int row, int lane) {
    float* DS = (float*)(a.ws + WS_DS);
    const float* src = (tab ? a.in[22] : a.in[21]) + (size_t)row * D + 4 * lane;
    f32x4 v[2][8]; float mx[2] = {0.f, 0.f};
#pragma unroll
    for (int r = 0; r < 2; ++r)
#pragma unroll
        for (int j = 0; j < 8; ++j) v[r][j] = __builtin_nontemporal_load((const f32x4*)(src + (size_t)r * D + 256 * j));
#pragma unroll
    for (int r = 0; r < 2; ++r) {
#pragma unroll
        for (int j = 0; j < 8; ++j) mx[r] = fmaxf(mx[r], fmaxf(fmaxf(fabsf(v[r][j][0]), fabsf(v[r][j][1])), fmaxf(fabsf(v[r][j][2]), fabsf(v[r][j][3]))));
#pragma unroll
        for (int o = 1; o < 64; o <<= 1) mx[r] = fmaxf(mx[r], __shfl_xor(mx[r], o)); }
#pragma unroll
    for (int r = 0; r < 2; ++r) { const int rw = row + r;
        const float sc = mx[r] > 0.f ? 127.0f / mx[r] : 1.0f;
        if (lane == 0) DS[(size_t)tab * DEPTH * NE + rw] = mx[r] > 0.f ? mx[r] * (1.0f / 127.0f) : 1.0f;
        unsigned char* dstb = (tab ? a.ws + WS_PV : a.ws + WS_PU) + (size_t)(rw / NE) * NE * D + (size_t)(rw % NE) * 128;
#pragma unroll
        for (int j = 0; j < 8; ++j) { const unsigned w = pack_i8(v[r][j][0] * sc, v[r][j][1] * sc, v[r][j][2] * sc, v[r][j][3] * sc);
            const int bo = 4 * (lane + 64 * j); __builtin_nontemporal_store(w, (unsigned*)(dstb + (size_t)(bo >> 7) * NE * 128 + (bo & 127))); } }
}
__device__ __forceinline__ void p0_prologue(const Args& a, LAS unsigned char* lds, int tid, int lane, int wave) {
    const int G = gridDim.x, bx = blockIdx.x;
    {
        LAS float* cact = (LAS float*)lds; LAS float* red = (LAS float*)(lds + 32768);
        for (int i = tid; i < NB * D; i += NTHR) { const float v = a.in[1][i]; cact[i] = v / (1.0f + __expf(-v)); }
        __syncthreads();
        float* modv = (float*)(a.ws + WS_MOD);
        for (int it = bx; it < 2 * (NMOD / 64); it += G) {
            const int l = it / (NMOD / 64), j0 = (it % (NMOD / 64)) * 64;
            const float* W = a.in[2] + ((size_t)l * D + wave * 256) * NMOD + j0 + lane;
            float a0 = 0.f, a1 = 0.f, a2 = 0.f, a3 = 0.f;
#pragma unroll 32
            for (int k = 0; k < 256; ++k) { const float w = W[(size_t)k * NMOD]; const int kk = wave * 256 + k; a0 += cact[kk] * w; a1 += cact[D + kk] * w; a2 += cact[2 * D + kk] * w; a3 += cact[3 * D + kk] * w; }
            red[(wave * 4 + 0) * 64 + lane] = a0; red[(wave * 4 + 1) * 64 + lane] = a1; red[(wave * 4 + 2) * 64 + lane] = a2; red[(wave * 4 + 3) * 64 + lane] = a3;
            __syncthreads();
            if (tid < 256) { const int b = tid >> 6; float s = a.in[3][l * NMOD + j0 + lane];
#pragma unroll
                for (int w = 0; w < 8; ++w) s += red[(w * 4 + b) * 64 + lane];
                modv[(size_t)(l * NB + b) * NMOD + j0 + lane] = s; }
            __syncthreads();
        }
    }
    for (int it = bx; it < DEPTH * 64; it += G) ssm_tables_item(a, lds, it >> 6, it & 63, tid);
    __syncthreads();
    {
        LAS float* scr = (LAS float*)(lds + 49152 + wave * 8704);
        const int gw = bx * NWAVES + wave, NGW = G * NWAVES;
        constexpr int I_GLU = 16 * 32, I_OUT = WQ_I8 ? 0 : 32 * 64, I_L = I_GLU + I_OUT;
        for (int it = gw; it < DEPTH * I_L; it += NGW) {
            const int l = it / I_L; int r = it % I_L;
            if (r < I_GLU) { p0_transpose_item(a.in[15] + (size_t)l * 1024 * 1024, 1024, 1024, (bf16*)(a.ws + WS_WGLU) + (size_t)l * 1024 * 1024, scr, r, lane); continue; } r -= I_GLU;
            if (!WQ_I8) p0_transpose_item(a.in[19] + (size_t)l * D * D, D, D, (bf16*)(a.ws + WS_WQ) + (size_t)l * D * D, scr, r, lane);
        }
    }
#if WCOL
    __syncthreads();
    wconv_all(a, lds, lane, wave);
#ifdef WCONV_TWICE
    wconv_all(a, lds, lane, wave);
#endif
#endif
    {
        const int gw = bx * NWAVES + wave, NGW = G * NWAVES;
        float* DS = (float*)(a.ws + WS_DS);
        unsigned* qhead = (unsigned*)(a.ws + WS_CTL) + CW_QPRO;
        constexpr int NL0 = PEER_DEFER ? 1 : DEPTH;
        for (;;) { unsigned c0 = 0; if (lane == 0) c0 = __hip_atomic_fetch_add(qhead, 1u, __ATOMIC_RELAXED, __HIP_MEMORY_SCOPE_AGENT); c0 = (unsigned)__builtin_amdgcn_readfirstlane((int)c0); if (c0 >= (unsigned)(2 * NL0 * NE / 16)) break;
        for (int rr = (int)c0 * 16; rr < (int)c0 * 16 + 16; rr += 2) { const int tab = rr >= NL0 * NE; peer_conv_row2(a, tab, rr - tab * NL0 * NE, lane); }
        }
        const size_t gt = (size_t)bx * NTHR + tid, GT = (size_t)G * NTHR;
        for (size_t i = gt; i < (size_t)(2 * 2 * 128 * 128 / 8); i += GT) cvt8(a.in[20], (bf16*)(a.ws + WS_SKB), i);
    }
#if !WCOL
    win_absmax(a, tid, lane);
#endif
}
template <int MODE> __device__ __forceinline__ void modnorm_core(f32x4 (&v)[8], const float* gain, const float* sc, const float* sh, bf16* orow, int lane, unsigned char* o8, float* hs);
template <int MODE, bool XBF = false> __device__ __forceinline__ void modnorm_row(const void* xrow_, const float* gain, const float* sc, const float* sh, bf16* orow, int lane, unsigned char* o8 = nullptr, float* hs = nullptr) {
    f32x4 v[8];
#pragma unroll
    for (int j = 0; j < 8; ++j) {
        if (XBF) { const v2u w = *(const v2u*)((const bf16*)xrow_ + 4 * lane + 256 * j); v[j] = (f32x4){bf_lo(w.x), bf_hi(w.x), bf_lo(w.y), bf_hi(w.y)}; } else v[j] = *(const f32x4*)((const float*)xrow_ + 4 * lane + 256 * j); }
    modnorm_core<MODE>(v, gain, sc, sh, orow, lane, o8, hs);
}
template <int MODE> __device__ __forceinline__ void modnorm_raw(const v2u (&raw)[8], const float* gain, const float* sc, const float* sh, bf16* orow, int lane, unsigned char* o8, float* hs) {
    f32x4 v[8];
#pragma unroll
    for (int j = 0; j < 8; ++j) v[j] = (f32x4){bf_lo(raw[j].x), bf_hi(raw[j].x), bf_lo(raw[j].y), bf_hi(raw[j].y)};
    modnorm_core<MODE>(v, gain, sc, sh, orow, lane, o8, hs);
}
__device__ __forceinline__ void modnorm_pre(const v2u (&raw)[8], const f32x4 (&gs)[8], const f32x4 (&shv)[8], int lane, unsigned char* o8, float* hs) {
    f32x4 v[8]; float s = 0.f;
#pragma unroll
    for (int j = 0; j < 8; ++j) { v[j] = (f32x4){bf_lo(raw[j].x), bf_hi(raw[j].x), bf_lo(raw[j].y), bf_hi(raw[j].y)}; s += (v[j][0] * v[j][0] + v[j][1] * v[j][1]) + (v[j][2] * v[j][2] + v[j][3] * v[j][3]); }
    const float rstd = 1.0f / sqrtf(wave_sum(s) * (1.0f / D) + EPS); float mx = 0.f;
#pragma unroll
    for (int j = 0; j < 8; ++j) { const f32x4 o = v[j] * rstd * gs[j] + shv[j]; v[j] = o; mx = fmaxf(mx, fmaxf(fmaxf(fabsf(o[0]), fabsf(o[1])), fmaxf(fabsf(o[2]), fabsf(o[3])))); }
#pragma unroll
    for (int o = 1; o < 64; o <<= 1) mx = fmaxf(mx, __shfl_xor(mx, o));
    const float q = mx > 0.f ? 127.0f / mx : 1.0f; if (lane == 0) *hs = mx > 0.f ? mx / 127.0f : 1.0f;
#pragma unroll
    for (int j = 0; j < 8; ++j) *(unsigned*)(o8 + 4 * lane + 256 * j) = pack_i8(v[j][0] * q, v[j][1] * q, v[j][2] * q, v[j][3] * q);
}
__device__ __forceinline__ void modnorm_pre_f(f32x4 (&v)[8], const f32x4 (&gs)[8], const f32x4 (&shv)[8], int lane, unsigned char* o8, float* hs) {
    float s = 0.f;
#pragma unroll
    for (int j = 0; j < 8; ++j) s += (v[j][0] * v[j][0] + v[j][1] * v[j][1]) + (v[j][2] * v[j][2] + v[j][3] * v[j][3]);
    const float rstd = 1.0f / sqrtf(wave_sum(s) * (1.0f / D) + EPS); float mx = 0.f;
#pragma unroll
    for (int j = 0; j < 8; ++j) { const f32x4 o = v[j] * rstd * gs[j] + shv[j]; v[j] = o; mx = fmaxf(mx, fmaxf(fmaxf(fabsf(o[0]), fabsf(o[1])), fmaxf(fabsf(o[2]), fabsf(o[3])))); }
#pragma unroll
    for (int o = 1; o < 64; o <<= 1) mx = fmaxf(mx, __shfl_xor(mx, o));
    const float q = mx > 0.f ? 127.0f / mx : 1.0f; if (lane == 0) *hs = mx > 0.f ? mx / 127.0f : 1.0f;
#pragma unroll
    for (int j = 0; j < 8; ++j) *(unsigned*)(o8 + 4 * lane + 256 * j) = pack_i8(v[j][0] * q, v[j][1] * q, v[j][2] * q, v[j][3] * q);
}
template <bool XBF> __device__ __forceinline__ void norm_rows8(const void* X, const float* gain, const float* modl, int sc_off, int sh_off, int lane, int wave, unsigned char* H8, float* HS) {
    const int gw = blockIdx.x * NWAVES + wave, NGW = gridDim.x * NWAVES;
    typedef typename std::conditional<XBF, v2u, f32x4>::type raw_t;
    for (int m0 = gw * 8; m0 < M; m0 += NGW * 8) {
        const float* mb = modl + (size_t)(m0 / SEQ) * NMOD;
        raw_t xr[8], xn[8];
#pragma unroll
        for (int j = 0; j < 8; ++j) xr[j] = *(const raw_t*)((const char*)X + ((size_t)m0 * D + 4 * lane + 256 * j) * (XBF ? 2 : 4));
        f32x4 gs[8], shv[8];
#pragma unroll
        for (int j = 0; j < 8; ++j) { const int c = 4 * lane + 256 * j; gs[j] = *(const f32x4*)(gain + c) * (*(const f32x4*)(mb + sc_off + c) + 1.0f); shv[j] = *(const f32x4*)(mb + sh_off + c); }
#pragma unroll 1
        for (int i = 0; i < 8; ++i) { const int m = m0 + i, mn = m0 + (i + 1 < 8 ? i + 1 : 7);
#pragma unroll
            for (int j = 0; j < 8; ++j) xn[j] = *(const raw_t*)((const char*)X + ((size_t)mn * D + 4 * lane + 256 * j) * (XBF ? 2 : 4));
            f32x4 v[8];
#pragma unroll
            for (int j = 0; j < 8; ++j) { if constexpr (XBF) v[j] = (f32x4){bf_lo(xr[j].x), bf_hi(xr[j].x), bf_lo(xr[j].y), bf_hi(xr[j].y)}; else v[j] = xr[j]; }
            modnorm_pre_f(v, gs, shv, lane, H8 + (size_t)m * D, HS + m);
#pragma unroll
            for (int j = 0; j < 8; ++j) xr[j] = xn[j]; }
    }
}
template <int MODE> __device__ __forceinline__ void modnorm_core(f32x4 (&v)[8], const float* gain, const float* sc, const float* sh, bf16* orow, int lane, unsigned char* o8, float* hs) {
    float s = 0.f;
#pragma unroll
    for (int j = 0; j < 8; ++j) s += (v[j][0] * v[j][0] + v[j][1] * v[j][1]) + (v[j][2] * v[j][2] + v[j][3] * v[j][3]);
    const float rstd = 1.0f / sqrtf(wave_sum(s) * (1.0f / D) + EPS); float mx = 0.f;
#pragma unroll
    for (int j = 0; j < 8; ++j) { const int c = 4 * lane + 256 * j; const f32x4 gn = *(const f32x4*)(gain + c), scv = *(const f32x4*)(sc + c), shv = *(const f32x4*)(sh + c);
        const f32x4 o = v[j] * rstd * gn * (scv + 1.0f) + shv; v[j] = o;
        if (MODE == 0 || MODE == 2) { v2u w; w.x = cvt_pk_bf16(o[0], o[1]); w.y = cvt_pk_bf16(o[2], o[3]); *(v2u*)(orow + c) = w; }
        if (MODE != 0) mx = fmaxf(mx, fmaxf(fmaxf(fabsf(o[0]), fabsf(o[1])), fmaxf(fabsf(o[2]), fabsf(o[3])))); }
    if (MODE != 0) {
#pragma unroll
        for (int o = 1; o < 64; o <<= 1) mx = fmaxf(mx, __shfl_xor(mx, o));
        const float top = MODE == 1 ? 400.0f : 127.0f;
        const float q = mx > 0.f ? top / mx : 1.0f; if (lane == 0) *hs = mx > 0.f ? mx / top : 1.0f;
#pragma unroll
        for (int j = 0; j < 8; ++j) { unsigned w;
            if (MODE == 1) { int t = __builtin_amdgcn_cvt_pk_fp8_f32(v[j][0] * q, v[j][1] * q, 0, false); t = __builtin_amdgcn_cvt_pk_fp8_f32(v[j][2] * q, v[j][3] * q, t, true); w = (unsigned)t; }
            else w = pack_i8(v[j][0] * q, v[j][1] * q, v[j][2] * q, v[j][3] * q);
            *(unsigned*)(o8 + 4 * lane + 256 * j) = w; }
    }
}
template <int MODE, bool XBF = false> __device__ __forceinline__ void norm_phase(const void* X, const float* gain, const float* modl, int sc_off, int sh_off, bf16* H, int lane, int wave, unsigned char* H8 = nullptr, float* HS = nullptr) {
    const int gw = blockIdx.x * NWAVES + wave, NGW = gridDim.x * NWAVES;
    for (int m = gw; m < M; m += NGW) { const float* mb = modl + (size_t)(m / SEQ) * NMOD; modnorm_row<MODE, XBF>(XBF ? (const void*)((const bf16*)X + (size_t)m * D) : (const void*)((const float*)X + (size_t)m * D), gain, mb + sc_off, mb + sh_off, (MODE == 1 || MODE == 3) ? nullptr : H + (size_t)m * D, lane, MODE != 0 ? H8 + (size_t)m * D : nullptr, MODE != 0 ? HS + m : nullptr); }
}
__device__ __forceinline__ void win_absmax(const Args& a, int tid, int lane) {
    const size_t gt = (size_t)blockIdx.x * NTHR + tid, GT = (size_t)gridDim.x * NTHR;
    for (int lw = 0; lw < DEPTH * 4; ++lw) { const int l = lw >> 2, wi = lw & 3;
        const size_t nel = wi == 0 ? (size_t)D * INC : wi == 3 ? (size_t)D * D : (size_t)1024 * D;
        const f32x4* W = (const f32x4*)((wi == 0 ? a.in[6] : wi == 1 ? a.in[16] : wi == 2 ? a.in[17] : a.in[18]) + (size_t)l * nel); float mx = 0.f;
        for (size_t i = gt; i < nel / 4; i += GT) { const f32x4 v = W[i]; mx = fmaxf(mx, fmaxf(fmaxf(fabsf(v[0]), fabsf(v[1])), fmaxf(fabsf(v[2]), fabsf(v[3])))); }
#pragma unroll
        for (int o = 1; o < 64; o <<= 1) mx = fmaxf(mx, __shfl_xor(mx, o));
        if (lane == 0) atomicMax((unsigned*)(a.ws + WS_CTL) + CW_WMAX + 64 * lw, __float_as_uint(mx)); }
}
__device__ __forceinline__ float wscale(const Args& a, int l, int wi) {
    const float wmax = __uint_as_float(__hip_atomic_load((unsigned*)(a.ws + WS_CTL) + CW_WMAX + 64 * (4 * l + wi), __ATOMIC_RELAXED, __HIP_MEMORY_SCOPE_AGENT)); return wmax > 0.f ? wmax * (wi == 0 ? 1.0f / 127.0f : 1.0f / 400.0f) : 1.0f; }
__device__ __forceinline__ void w_to_fp8(const Args& a, LAS unsigned char* lds, int lane, int wave) {
    LAS float* scr = (LAS float*)(lds + 49152 + wave * 8704);
    const int gw = blockIdx.x * NWAVES + wave, NGW = gridDim.x * NWAVES;
    constexpr int I0 = 32 * 256, I1 = 16 * 64, I3 = 32 * 64, I_L = I0 + 2 * I1 + I3;
    for (int it = gw; it < DEPTH * I_L; it += NGW) {
        const int l = it / I_L; int item = it % I_L; int wi = 0, K = D, N = INC; const float* W = a.in[6] + (size_t)l * D * INC; unsigned char* WT = a.ws + WS_WIN + (size_t)l * INC * D;
        if (item >= I0) { item -= I0; wi = 1; K = 1024; N = D; W = a.in[16] + (size_t)l * 1024 * D; WT = a.ws + WS_WBRS + (size_t)l * D * 1024;
            if (item >= I1) { item -= I1; wi = 2; W = a.in[17] + (size_t)l * 1024 * D; WT = a.ws + WS_WBRA + (size_t)l * D * 1024;
                if (item >= I1) { item -= I1; wi = 3; K = D; W = a.in[18] + (size_t)l * D * D; WT = a.ws + WS_WOUT + (size_t)l * D * D; } } }
        const int nblk = N / 32, kb = item / nblk, nb = item % nblk, k0 = 64 * kb, n0 = 32 * nb;
        const float q = 1.0f / wscale(a, l, wi);
#pragma unroll 8
        for (int i = 0; i < 32; ++i) { const int kk = 2 * i + (lane >> 5); scr[kk * 33 + (lane & 31)] = W[(size_t)(k0 + kk) * N + n0 + (lane & 31)]; }
        asm volatile("s_waitcnt lgkmcnt(0)" ::: "memory");
        const int c = lane & 7;
#pragma unroll
        for (int j = 0; j < 4; ++j) { const int n = (lane >> 3) + 8 * j; const LAS float* s = scr + (8 * c) * 33 + n;
            unsigned w0, w1;
            if (wi == 0) { w0 = pack_i8(s[0 * 33] * q, s[1 * 33] * q, s[2 * 33] * q, s[3 * 33] * q); w1 = pack_i8(s[4 * 33] * q, s[5 * 33] * q, s[6 * 33] * q, s[7 * 33] * q); }
            else { int t0 = __builtin_amdgcn_cvt_pk_fp8_f32(s[0 * 33] * q, s[1 * 33] * q, 0, false); t0 = __builtin_amdgcn_cvt_pk_fp8_f32(s[2 * 33] * q, s[3 * 33] * q, t0, true);
                int t1 = __builtin_amdgcn_cvt_pk_fp8_f32(s[4 * 33] * q, s[5 * 33] * q, 0, false); t1 = __builtin_amdgcn_cvt_pk_fp8_f32(s[6 * 33] * q, s[7 * 33] * q, t1, true); w0 = (unsigned)t0; w1 = (unsigned)t1; }
            *(v2u*)(WT + (size_t)(n0 + n) * K + k0 + 8 * c) = (v2u){w0, w1}; }
        asm volatile("s_waitcnt lgkmcnt(0)" ::: "memory");
    }
}

__device__ __forceinline__ void ssm_fused(const Args& a, LAS unsigned char* lds, int l, int tid, int lane, int wave) {
    const bf16* ZU = (const bf16*)(a.ws + WS_ZU); float* HLOC = (float*)(a.ws + WS_HLOC); bf16* HPREV = (bf16*)(a.ws + WS_HPREV); const float* A16 = (const float*)(a.ws + WS_A16); bf16* Y = (bf16*)(a.ws + WS_Y);
#if SSM_LDS_STATE
    constexpr int L_TF = 0, L_WF = 16384, L_BF = 16384 + 65536, L_ST = L_BF, ST_STR = 272, ST_WAVE = 32 * ST_STR, L_EX = L_ST + 8 * ST_WAVE;
    static_assert(L_EX + 8 * 64 * 8 <= MISC_OFF, "SSM LDS layout");
#else
    constexpr int L_BF = 0, L_TF = 65536, L_WF = 65536 + 16384;
#endif
    for (int it = blockIdx.x; it < 256; it += gridDim.x) {
        const int g = it >> 2, nb = it & 3;
        { const v4u* s0 = (const v4u*)(a.ws + WS_BF + (size_t)(l * 64 + g) * 65536); const v4u* s1 = (const v4u*)(a.ws + WS_TF + (size_t)(l * 64 + g) * 16384); const v4u* s2 = (const v4u*)(a.ws + WS_WF + (size_t)(l * 64 + g) * 65536);
          for (int i = tid; i < 4096; i += NTHR) ((LAS v4u*)(lds + L_BF))[i] = s0[i];
          for (int i = tid; i < 1024; i += NTHR) ((LAS v4u*)(lds + L_TF))[i] = s1[i];
          for (int i = tid; i < 4096; i += NTHR) ((LAS v4u*)(lds + L_WF))[i] = s2[i]; }
        const int n = nb * 256 + wave * 32 + (lane & 31), h = lane >> 5;
        const bf16* zu = UGM ? ZU + ((size_t)g * M + n * 16) * 16 + 8 * h : ZU + (size_t)(n * 16) * 1024 + g * 16 + 8 * h;
        bf16x8 uf[16];
#pragma unroll
        for (int s = 0; s < 16; ++s) uf[s] = *(const bf16x8*)(zu + (size_t)s * (UGM ? 16 : 1024));
        __syncthreads();
        {
            f32x16 acc[4];
#pragma unroll
            for (int q = 0; q < 4; ++q)
#pragma unroll
                for (int r = 0; r < 16; ++r) acc[q][r] = 0.f;
#pragma unroll
            for (int s = 0; s < 16; ++s)
#pragma unroll
                for (int q = 0; q < 4; ++q) { const bf16x8 af = *(const LAS bf16x8*)(lds + L_BF + ((q * 16 + s) * 64 + lane) * 16); acc[q] = MFMA32(af, uf[s], acc[q]); }
#if SSM_LDS_STATE
            __syncthreads();
            LAS unsigned char* st = lds + L_ST + wave * ST_WAVE + (lane & 31) * ST_STR;
#pragma unroll
            for (int q = 0; q < 4; ++q)
#pragma unroll
                for (int v = 0; v < 4; ++v) *(LAS v2u*)(st + (32 * q + 8 * v + 4 * h) * 2) = (v2u){cvt_pk_bf16(acc[q][4 * v], acc[q][4 * v + 1]), cvt_pk_bf16(acc[q][4 * v + 2], acc[q][4 * v + 3])};
            asm volatile("s_waitcnt lgkmcnt(0)" ::: "memory");
        }
#else
            float* hl = HLOC + ((size_t)g * 1024 + n) * 128;
#pragma unroll
            for (int q = 0; q < 4; ++q)
#pragma unroll
                for (int v = 0; v < 4; ++v) *(f32x4*)(hl + 32 * q + 8 * v + 4 * h) = (f32x4){acc[q][4 * v], acc[q][4 * v + 1], acc[q][4 * v + 2], acc[q][4 * v + 3]};
        }
        __builtin_amdgcn_fence(__ATOMIC_RELEASE, "workgroup"); __syncthreads(); __builtin_amdgcn_fence(__ATOMIC_ACQUIRE, "workgroup");
#endif
        {
            const int p = lane; const float ar = A16[((l * 64 + g) * 64 + p) * 2], ai = A16[((l * 64 + g) * 64 + p) * 2 + 1];
            const float* hl = HLOC + ((size_t)g * 1024 + nb * 256 + wave * 32) * 128 + 2 * p; bf16* hp = HPREV + ((size_t)g * 1024 + nb * 256 + wave * 32) * 128 + 2 * p;
            f32x2 v[32];
#if SSM_LDS_STATE
            LAS unsigned char* stw = lds + L_ST + wave * ST_WAVE + 4 * p; (void)hl; (void)hp;
#pragma unroll
            for (int j = 0; j < 32; ++j) { const unsigned w = *(const LAS unsigned*)(stw + j * ST_STR); v[j] = (f32x2){bf_lo(w), bf_hi(w)}; }
#else
#pragma unroll
            for (int j = 0; j < 32; ++j) v[j] = *(const f32x2*)(hl + (size_t)j * 128);
#endif
            float er = 0.f, ei = 0.f;
#pragma unroll
            for (int j = 0; j < 32; ++j) { const float nr = ar * er - ai * ei + v[j][0], ni = ar * ei + ai * er + v[j][1]; er = nr; ei = ni; }
            float Ar = ar, Ai = ai;
#pragma unroll
            for (int q = 0; q < 5; ++q) { const float nr = Ar * Ar - Ai * Ai, ni = 2.0f * Ar * Ai; Ar = nr; Ai = ni; }
#if SSM_LDS_STATE
            LAS f32x2* ex = (LAS f32x2*)(lds + L_EX);
#else
            LAS f32x2* ex = (LAS f32x2*)(lds + 147456);
#endif
            ex[wave * 64 + p] = (f32x2){er, ei};
            __syncthreads();
            float hr = 0.f, hi = 0.f;
            for (int u = 0; u < wave; ++u) { const f32x2 e = ex[u * 64 + p]; const float nr = Ar * hr - Ai * hi + e[0], ni = Ar * hi + Ai * hr + e[1]; hr = nr; hi = ni; }
#pragma unroll
#if SSM_LDS_STATE
            for (int j = 0; j < 32; ++j) { *(LAS unsigned*)(stw + j * ST_STR) = cvt_pk_bf16(hr, hi); const float nr = ar * hr - ai * hi + v[j][0], ni = ar * hi + ai * hr + v[j][1]; hr = nr; hi = ni; }
            asm volatile("s_waitcnt lgkmcnt(0)" ::: "memory");
        }
#else
            for (int j = 0; j < 32; ++j) { *(unsigned*)(hp + (size_t)j * 128) = cvt_pk_bf16(hr, hi); const float nr = ar * hr - ai * hi + v[j][0], ni = ar * hi + ai * hr + v[j][1]; hr = nr; hi = ni; }
        }
        __builtin_amdgcn_fence(__ATOMIC_RELEASE, "workgroup"); __syncthreads(); __builtin_amdgcn_fence(__ATOMIC_ACQUIRE, "workgroup");
#endif
        {
            bf16x8 hpf[8];
#if SSM_LDS_STATE
            const LAS unsigned char* st2 = lds + L_ST + wave * ST_WAVE + (lane & 31) * ST_STR + 16 * h;
#pragma unroll
            for (int kk = 0; kk < 8; ++kk) hpf[kk] = *(const LAS bf16x8*)(st2 + 32 * kk);
#else
            const bf16* hp = HPREV + ((size_t)g * 1024 + n) * 128 + 8 * h;
#pragma unroll
            for (int kk = 0; kk < 8; ++kk) hpf[kk] = *(const bf16x8*)(hp + 16 * kk);
#endif
#pragma unroll
            for (int ti = 0; ti < 8; ++ti) {
                f32x16 acc;
#pragma unroll
                for (int r = 0; r < 16; ++r) acc[r] = 0.f;
#pragma unroll
                for (int kk = 0; kk < 8; ++kk) { const bf16x8 af = *(const LAS bf16x8*)(lds + L_WF + ((ti * 8 + kk) * 64 + lane) * 16); acc = MFMA32(af, hpf[kk], acc); }
#pragma unroll
                for (int s = 0; s <= 2 * ti + 1; ++s) { const bf16x8 af = *(const LAS bf16x8*)(lds + L_TF + ((2 * ti - s + 1) * 64 + lane) * 16); acc = MFMA32(af, uf[s], acc); }
#pragma unroll
                for (int dt = 0; dt < 2; ++dt) { bf16* yrow = YGM ? Y + ((size_t)g * M + (n * 16 + 2 * ti + dt)) * 16 + 4 * h : Y + (size_t)(n * 16 + 2 * ti + dt) * 1024 + g * 16 + 4 * h;
#pragma unroll
                    for (int hh = 0; hh < 2; ++hh) { const int r0 = (2 * dt + hh) * 4;
                        const f32x2 ga = gelu_pk((f32x2){acc[r0], acc[r0 + 1]}), gb = gelu_pk((f32x2){acc[r0 + 2], acc[r0 + 3]});
                        v2u w; w.x = cvt_pk_bf16(ga.x, ga.y); w.y = cvt_pk_bf16(gb.x, gb.y); *(v2u*)(yrow + 8 * hh) = w; } }
            }
        }
        __syncthreads();
    }
}
#ifndef XB_NT_ST
#define XB_NT_ST 0
#endif
#ifndef PEER_VMFMA
#define PEER_VMFMA 1
#endif
struct PeerMap { int fast, x, r; };
__device__ __forceinline__ int attn_item(const PeerMap& pm, int k) {
    if (pm.fast) { if (k >= 12) return -1; const int pair = 4 * pm.x + k / 3, j = pm.r + 32 * (k % 3); return ((j >> 5) << 10) | ((pair >> 3) << 8) | ((pair & 7) << 5) | (j & 31); }
    const int idx = (int)blockIdx.x + k * (int)gridDim.x; return idx < 3072 ? idx : -1;
}
constexpr int AT_KSTR = 272, AT_VSTR = 288, AT_VOFF = 256 * AT_KSTR;
__device__ __forceinline__ s16x4 tr_read(const LAS unsigned char* p) { typedef short v4i16_t __attribute__((ext_vector_type(4))); return __builtin_bit_cast(s16x4, __builtin_amdgcn_ds_read_tr16_b64_v4i16((LAS v4i16_t*)p)); }
#define AT_DECODE(idx_, p_, b_, hh_, d_, r_, n_) do { p_ = (idx_) >> 10; const int rem_ = (idx_) & 1023; b_ = rem_ >> 8; hh_ = (rem_ >> 5) & 7; \
        const int w5_ = ((rem_ & 31) + 8 * (b_) * (p_)) & 31;        \
        d_ = 2 * p_; r_ = w5_ & ((1 << d_) - 1); n_ = w5_ >> d_; } while (0)
#define AT_LOAD(REG, coff_, b_, hh_, d_, r_, n_) do { _Pragma("unroll") for (int i8 = 0; i8 < 8; ++i8) { const int i_ = tid + i8 * NTHR, j_ = i_ >> 4, ch_ = i_ & 15; int sub_ = 128 * ((n_) - 1) + j_; sub_ = sub_ < 0 ? 0 : sub_; \
        REG[i8] = *(const v4u*)((coff_) + ((size_t)(((b_) << 12) + (sub_ << (d_)) + (r_)) << 10) + ((hh_) << 7) + (ch_ << 3)); } } while (0)
#define AT_STORE(REG, base_, str_) do { _Pragma("unroll") for (int i8 = 0; i8 < 8; ++i8) { const int i_ = tid + i8 * NTHR, j_ = i_ >> 4, ch_ = i_ & 15; *(LAS v4u*)(lds + (base_) + (j_ << 8) + j_ * ((str_) - 256) + (ch_ << 4)) = REG[i8]; } } while (0)
#define AT_LOADQ(QF, b_, hh_, d_, r_, n_) do { const bf16* qrow_ = ZQ + ((size_t)(((b_) << 12) + ((128 * (n_) + 16 * wave + ii) << (d_)) + (r_)) << 10) + ((hh_) << 7) + 8 * g4; \
        _Pragma("unroll") for (int s_ = 0; s_ < 4; ++s_) QF[s_] = *(const bf16x8*)(qrow_ + 32 * s_); } while (0)
__device__ __forceinline__ void attn_phase(const Args& a, LAS unsigned char* lds, const PeerMap& pm, int tid, int lane, int wave) {
    const bf16* ZQ = (const bf16*)(a.ws + WS_ZQ); const bf16* ZK = (const bf16*)(a.ws + WS_ZK); const bf16* ZV = (const bf16*)(a.ws + WS_ZV); bf16* OB = (bf16*)(a.ws + WS_OB); float* LSE = (float*)(a.ws + WS_LSE);
    const int ii = lane & 15, g4 = lane >> 4;
    { unsigned zz = 0u; asm volatile("" : "+v"(zz));
      for (int i = tid; i < 16 * AT_VSTR / 16; i += NTHR) *(LAS v4u*)(lds + AT_VOFF + 256 * AT_VSTR + i * 16) = (v4u){zz, zz, zz, zz}; }
    int kit = 0; int idx = attn_item(pm, 0); if (idx < 0) return;
    int p, b, hh, d, r, n; AT_DECODE(idx, p, b, hh, d, r, n);
    v4u kreg[8], vreg[8]; bf16x8 qf[4];
    AT_LOAD(kreg, ZK, b, hh, d, r, n); AT_LOAD(vreg, ZV, b, hh, d, r, n); AT_LOADQ(qf, b, hh, d, r, n);
    AT_STORE(kreg, 0, AT_KSTR);
#pragma unroll 1
    for (;;) {
        const int idn = attn_item(pm, kit + 1); const bool more = idn >= 0;
        int pN, bN, hhN, dN, rN, nN; AT_DECODE(more ? idn : idx, pN, bN, hhN, dN, rN, nN);
        __syncthreads();
        AT_STORE(vreg, AT_VOFF, AT_VSTR);
        AT_LOAD(kreg, ZK, bN, hhN, dN, rN, nN);
        const int tq = (b << 12) + ((128 * n + 16 * wave + ii) << d) + r;
        const int kb_lo = (n == 0) ? 8 : wave;
        f32x4 sc[9];
#pragma unroll
        for (int bi = 0; bi < 9; ++bi) { const int kb = wave + bi;
            f32x4 acc = (f32x4){0.f, 0.f, 0.f, 0.f};
            if (kb >= kb_lo) {
#pragma unroll
                for (int s = 0; s < 4; ++s) { const bf16x8 kf = *(const LAS bf16x8*)(lds + (16 * kb + ii) * AT_KSTR + (32 * s + 8 * g4) * 2); acc = MFMA16(kf, qf[s], acc); }
            }
#pragma unroll
            for (int rg = 0; rg < 4; ++rg) { const int jj = 4 * g4 + rg; bool ok = kb >= kb_lo; if (bi == 0) ok = ok && (jj >= ii); if (bi == 8) ok = ok && (jj <= ii); sc[bi][rg] = ok ? acc[rg] : -1e30f; }
        }
        float mx = -1e30f;
#pragma unroll
        for (int bi = 0; bi < 9; ++bi)
#pragma unroll
            for (int rg = 0; rg < 4; ++rg) mx = fmaxf(mx, sc[bi][rg]);
        mx = fmaxf(mx, __shfl_xor(mx, 16)); mx = fmaxf(mx, __shfl_xor(mx, 32));
        const float c2 = 0.08838834764831845f * 1.4426950408889634f;
        float lsum = 0.f;
#pragma unroll
        for (int bi = 0; bi < 9; ++bi)
#pragma unroll
            for (int rg = 0; rg < 4; ++rg) { const float pv = __builtin_amdgcn_exp2f((sc[bi][rg] - mx) * c2); sc[bi][rg] = pv; lsum += pv; }
        lsum += __shfl_xor(lsum, 16); lsum += __shfl_xor(lsum, 32);
        bf16x8 pf[5];
#pragma unroll
        for (int ks = 0; ks < 5; ++ks) { v4u w; w.x = cvt_pk_bf16(sc[2 * ks][0], sc[2 * ks][1]); w.y = cvt_pk_bf16(sc[2 * ks][2], sc[2 * ks][3]);
            if (ks < 4) { w.z = cvt_pk_bf16(sc[2 * ks + 1][0], sc[2 * ks + 1][1]); w.w = cvt_pk_bf16(sc[2 * ks + 1][2], sc[2 * ks + 1][3]); } else { w.z = 0u; w.w = 0u; }
            pf[ks] = __builtin_bit_cast(bf16x8, w); }
        __syncthreads();
        AT_STORE(kreg, 0, AT_KSTR);
        AT_LOAD(vreg, ZV, bN, hhN, dN, rN, nN); AT_LOADQ(qf, bN, hhN, dN, rN, nN);
        f32x4 oacc[8];
#pragma unroll
        for (int eb = 0; eb < 8; ++eb) oacc[eb] = (f32x4){0.f, 0.f, 0.f, 0.f};
#pragma unroll
        for (int ks = 0; ks < 5; ++ks) {
            if (wave + 2 * ks + 1 >= kb_lo) {
                const LAS unsigned char* vb = lds + AT_VOFF + (16 * (wave + 2 * ks) + 4 * g4 + (ii >> 2)) * AT_VSTR + 4 * (ii & 3) * 2;
#pragma unroll
                for (int eb = 0; eb < 8; ++eb) { const s16x4 lo = tr_read(vb + eb * 32), hi = tr_read(vb + 16 * AT_VSTR + eb * 32);
                    const bf16x8 af = (bf16x8){lo[0], lo[1], lo[2], lo[3], hi[0], hi[1], hi[2], hi[3]}; oacc[eb] = MFMA16(af, pf[ks], oacc[eb]); }
            }
        }
        const float inv = 1.0f / lsum;
        bf16* orow = OB + ((size_t)p * M + tq) * 1024 + hh * 128 + 4 * g4;
#pragma unroll
        for (int eb = 0; eb < 8; ++eb) { v2u w; w.x = cvt_pk_bf16(oacc[eb][0] * inv, oacc[eb][1] * inv); w.y = cvt_pk_bf16(oacc[eb][2] * inv, oacc[eb][3] * inv); *(v2u*)(orow + 16 * eb) = w; }
        if (g4 == 0) LSE[((size_t)p * M + tq) * 8 + hh] = mx * 0.08838834764831845f + __logf(lsum);
        if (!more) break;
        idx = idn; ++kit; p = pN; b = bN; hh = hhN; d = dN; r = rN; n = nN;
    }
    __syncthreads();
}
constexpr float YA_Q = 8.0f, MG_Q = 4.0f;
#ifndef CMB_U
#define CMB_U 8
#endif
__device__ __forceinline__ void attn_combine(const Args& a, int tid) {
    const bf16* OB = (const bf16*)(a.ws + WS_OB); const float* LSE = (const float*)(a.ws + WS_LSE); unsigned char* YA8 = a.ws + WS_YA;
    const size_t gt = (size_t)blockIdx.x * NTHR + tid, GT = (size_t)gridDim.x * NTHR;
    for (size_t i0 = gt; i0 < (size_t)M * 128; i0 += CMB_U * GT) {
        float l0[CMB_U], l1[CMB_U], l2[CMB_U]; v4u o0[CMB_U], o1[CMB_U], o2[CMB_U];
#pragma unroll
        for (int u = 0; u < CMB_U; ++u) { size_t i = i0 + (size_t)u * GT; if (i >= (size_t)M * 128) i = i0; const size_t t = i >> 7; const int ch = (int)(i & 127), hh = ch >> 4;
            l0[u] = LSE[(0 * (size_t)M + t) * 8 + hh]; l1[u] = LSE[(1 * (size_t)M + t) * 8 + hh]; l2[u] = LSE[(2 * (size_t)M + t) * 8 + hh];
            o0[u] = *(const v4u*)(OB + (0 * (size_t)M + t) * 1024 + ch * 8); o1[u] = *(const v4u*)(OB + (1 * (size_t)M + t) * 1024 + ch * 8); o2[u] = *(const v4u*)(OB + (2 * (size_t)M + t) * 1024 + ch * 8); }
#pragma unroll
        for (int u = 0; u < CMB_U; ++u) { const size_t i = i0 + (size_t)u * GT; if (i >= (size_t)M * 128) break; const size_t t = i >> 7; const int ch = (int)(i & 127);
            const float mx = fmaxf(l0[u], fmaxf(l1[u], l2[u])); float w0 = __expf(l0[u] - mx), w1 = __expf(l1[u] - mx), w2 = __expf(l2[u] - mx); const float inv = 1.0f / (w0 + w1 + w2); w0 *= inv; w1 *= inv; w2 *= inv;
            float o[8];
#pragma unroll
            for (int k = 0; k < 4; ++k) { o[2 * k] = w0 * bf_lo(o0[u][k]) + w1 * bf_lo(o1[u][k]) + w2 * bf_lo(o2[u][k]); o[2 * k + 1] = w0 * bf_hi(o0[u][k]) + w1 * bf_hi(o1[u][k]) + w2 * bf_hi(o2[u][k]); }
            unsigned p0, p1; pg8::pk8_fp8(o, YA_Q, p0, p1);
            *(v2u*)(YA8 + t * 1024 + ch * 8) = (v2u){p0, p1}; }
    }
}

__device__ __forceinline__ unsigned f2ord(float f) { const unsigned u = __float_as_uint(f); return (u & 0x80000000u) ? ~u : (u | 0x80000000u); }
__device__ __forceinline__ float ord2f(unsigned k) { return __uint_as_float((k & 0x80000000u) ? (k ^ 0x80000000u) : ~k); }
__device__ __forceinline__ unsigned umax(unsigned a, unsigned b) { return a > b ? a : b; }
__device__ __forceinline__ unsigned umin(unsigned a, unsigned b) { return a < b ? a : b; }
__device__ __forceinline__ void sort16_desc(unsigned (&v)[16]) {
#define S16_CE(a_, b_) { const unsigned x_ = v[a_], y_ = v[b_]; v[a_] = umax(x_, y_); v[b_] = umin(x_, y_); }
    S16_CE(0, 13) S16_CE(1, 12) S16_CE(2, 15) S16_CE(3, 14) S16_CE(4, 8) S16_CE(5, 6) S16_CE(7, 11) S16_CE(9, 10)
    S16_CE(0, 5) S16_CE(1, 7) S16_CE(2, 9) S16_CE(3, 4) S16_CE(6, 13) S16_CE(8, 14) S16_CE(10, 15) S16_CE(11, 12)
    S16_CE(0, 1) S16_CE(2, 3) S16_CE(4, 5) S16_CE(6, 8) S16_CE(7, 9) S16_CE(10, 11) S16_CE(12, 13) S16_CE(14, 15)
    S16_CE(0, 2) S16_CE(1, 3) S16_CE(4, 10) S16_CE(5, 11) S16_CE(6, 7) S16_CE(8, 9) S16_CE(12, 14) S16_CE(13, 15)
    S16_CE(1, 2) S16_CE(3, 12) S16_CE(4, 6) S16_CE(5, 7) S16_CE(8, 10) S16_CE(9, 11) S16_CE(13, 14)
    S16_CE(1, 4) S16_CE(2, 6) S16_CE(5, 8) S16_CE(7, 10) S16_CE(9, 13) S16_CE(11, 14)
    S16_CE(2, 4) S16_CE(3, 6) S16_CE(9, 12) S16_CE(11, 13)
    S16_CE(3, 5) S16_CE(6, 8) S16_CE(7, 9) S16_CE(10, 12)
    S16_CE(3, 4) S16_CE(5, 6) S16_CE(7, 8) S16_CE(9, 10) S16_CE(11, 12)
    S16_CE(6, 7) S16_CE(8, 9)
#undef S16_CE
}
__device__ __forceinline__ void merge_top16(unsigned (&x)[16], const unsigned (&y)[16]) {
#pragma unroll
    for (int i = 0; i < 16; ++i) x[i] = umax(x[i], y[15 - i]);
#pragma unroll
    for (int j = 8; j > 0; j >>= 1)
#pragma unroll
        for (int i = 0; i < 16; ++i) { const int l = i ^ j; if (l > i) { const unsigned p = x[i], q = x[l]; x[i] = umax(p, q); x[l] = umin(p, q); } }
}
__device__ __forceinline__ void xmerge_top16(unsigned (&x)[16]) {
    unsigned y[16];
#pragma unroll
    for (int i = 0; i < 16; ++i) y[i] = (unsigned)__shfl_xor((int)x[i], 32);
    merge_top16(x, y);
}
constexpr int TK_SKSTR = 272, TK_HALF = 128 * TK_SKSTR, TK_SCR = 2 * TK_HALF, TK_IJ = TK_SCR + 8 * 1024;
__device__ __forceinline__ void topk_half(const LAS unsigned char* skb, const bf16* qrow, int lane, unsigned (&top)[16]) {
    const int r = lane & 31, hq = lane >> 5;
    bf16x8 qf[8];
#pragma unroll
    for (int ks = 0; ks < 8; ++ks) qf[ks] = *(const bf16x8*)(qrow + 16 * ks + 8 * hq);
#pragma unroll
    for (int kt = 0; kt < 4; ++kt) {
        f32x16 acc;
#pragma unroll
        for (int i = 0; i < 16; ++i) acc[i] = 0.f;
#pragma unroll
        for (int ks = 0; ks < 8; ++ks) { const bf16x8 af = *(const LAS bf16x8*)(skb + (32 * kt + r) * TK_SKSTR + (16 * ks + 8 * hq) * 2); acc = MFMA32(af, qf[ks], acc); }
        unsigned cur[16];
#pragma unroll
        for (int i = 0; i < 16; ++i) { const unsigned kidx = (unsigned)(32 * kt + (i & 3) + 8 * (i >> 2) + 4 * hq); cur[i] = (f2ord(acc[i]) & ~127u) | kidx; }
        sort16_desc(cur);
        if (kt == 0) {
#pragma unroll
            for (int i = 0; i < 16; ++i) top[i] = cur[i];
        } else merge_top16(top, cur);
    }
    xmerge_top16(top);
}
__device__ __forceinline__ void topk_phase(const Args& a, LAS unsigned char* lds, int l, int tid, int lane, int wave, int jb, int je, int js, bool setup, LAS unsigned short* ids_lds = nullptr, int tok_base = 0) {
    const bf16* QP = (const bf16*)(a.ws + WS_QP); const bf16* SKB = (const bf16*)(a.ws + WS_SKB) + (size_t)l * 2 * 128 * 128; int* IDS = (int*)(a.ws + WS_IDS); float* GATE = (float*)(a.ws + WS_GATE);
    if (setup) {
    for (int i = tid; i < 2 * 128 * 16; i += NTHR) { const int row = i >> 4, ch = i & 15; *(LAS v4u*)(lds + (row >> 7) * TK_HALF + (row & 127) * TK_SKSTR + ch * 16) = *(const v4u*)(SKB + (size_t)row * 128 + ch * 8); }
    if (tid < 64) { int cnt = 0, ij = 0;
        for (int i = 0; i < 16; ++i) for (int j = 0; j < 16; ++j) if ((i + 1) * (j + 1) <= 16) { ij = (cnt == tid) ? (i * 16 + j) : ij; ++cnt; }
        ((LAS unsigned char*)(lds + TK_IJ))[tid] = (unsigned char)ij; }
    __syncthreads();
    }
    const int r = lane & 31, hq = lane >> 5;
    LAS unsigned char* scr = lds + TK_SCR + wave * 1024 + r * 32;
    for (int job = jb; job < je; job += js) {
        const int tt = job >> 3, hd = job & 7; const int tok = tt * 32 + r;
        const bf16* qrow = QP + (size_t)tok * D + hd * 256;
        unsigned t1[16], t2[16];
        topk_half(lds, qrow, lane, t1);
        __builtin_amdgcn_sched_barrier(0);
        topk_half(lds + TK_HALF, qrow + 128, lane, t2);
        __builtin_amdgcn_sched_barrier(0);
        float v1[16], v2[16];
#pragma unroll
        for (int i = 0; i < 16; ++i) { v1[i] = ord2f(t1[i] & ~127u); v2[i] = ord2f(t2[i] & ~127u); }
        unsigned ca[32], cb[32];
#pragma unroll
        for (int i = 0; i < 32; ++i) { ca[i] = 0u; cb[i] = 0u; }
        {
            int c = 0;
#pragma unroll
            for (int i = 0; i < 16; ++i)
#pragma unroll
                for (int j = 0; j < 16; ++j)
                    if ((i + 1) * (j + 1) <= 16) { const unsigned key = (f2ord(v1[i] + v2[j]) & ~63u) | (unsigned)c; if (c < 32) ca[c] = key; else cb[c - 32] = key; ++c; }
        }
        unsigned m0[16], m1[16]; const unsigned smhi = hq ? 0xffffffffu : 0u, smlo = ~smhi;
#pragma unroll
        for (int i = 0; i < 16; ++i) { m0[i] = (ca[i] & smlo) | (cb[i] & smhi); m1[i] = (ca[16 + i] & smlo) | (cb[16 + i] & smhi); }
        sort16_desc(m0); sort16_desc(m1); merge_top16(m0, m1); xmerge_top16(m0);
        float sv[16]; float se = 0.f;
#pragma unroll
        for (int i = 0; i < 16; ++i) { sv[i] = __expf(ord2f(m0[i] & ~63u) - ord2f(m0[0] & ~63u)); se += sv[i]; }
        const float inv = 1.0f / se;
        if (hq == 0) {
#pragma unroll
            for (int q = 0; q < 4; ++q) { ((LAS unsigned*)scr)[q] = (t1[4 * q] & 127u) | ((t1[4 * q + 1] & 127u) << 8) | ((t1[4 * q + 2] & 127u) << 16) | ((t1[4 * q + 3] & 127u) << 24);
                ((LAS unsigned*)scr)[4 + q] = (t2[4 * q] & 127u) | ((t2[4 * q + 1] & 127u) << 8) | ((t2[4 * q + 2] & 127u) << 16) | ((t2[4 * q + 3] & 127u) << 24); }
        }
        asm volatile("s_waitcnt lgkmcnt(0)" ::: "memory");
        v2u outv[8]; const unsigned mhi = hq ? 0xffffffffu : 0u, mlo = ~mhi;
#pragma unroll
        for (int k = 0; k < 8; ++k) { const unsigned key = (m0[k] & mlo) | (m0[8 + k] & mhi); const float gt = __uint_as_float((__float_as_uint(sv[k]) & mlo) | (__float_as_uint(sv[8 + k]) & mhi)) * inv;
            const unsigned ij = ((const LAS unsigned char*)(lds + TK_IJ))[key & 63u]; const unsigned e1 = scr[ij >> 4], e2 = scr[16 + (ij & 15u)];
            outv[k].x = e1 * 128u + e2; outv[k].y = __float_as_uint(gt); }
        const size_t so = (size_t)tok * 128 + hd * 16 + 8 * hq;
        *(v4u*)(IDS + so) = (v4u){outv[0].x, outv[1].x, outv[2].x, outv[3].x}; *(v4u*)(IDS + so + 4) = (v4u){outv[4].x, outv[5].x, outv[6].x, outv[7].x};
        { const v4u pk_ = (v4u){outv[0].x | (outv[1].x << 16), outv[2].x | (outv[3].x << 16), outv[4].x | (outv[5].x << 16), outv[6].x | (outv[7].x << 16)};
          if (ids_lds) *(LAS v4u*)(ids_lds + (size_t)(tok - tok_base) * 128 + hd * 16 + 8 * hq) = pk_; else *(v4u*)((unsigned short*)(a.ws + WS_IDS16) + so) = pk_; }
        *(v4u*)(GATE + so) = (v4u){outv[0].y, outv[1].y, outv[2].y, outv[3].y}; *(v4u*)(GATE + so + 4) = (v4u){outv[4].y, outv[5].y, outv[6].y, outv[7].y};
        asm volatile("s_waitcnt lgkmcnt(0)" ::: "memory");
    }
}

#ifndef GATHER_REP
#define GATHER_REP 1
#endif
__device__ __forceinline__ void gather_phase(const Args& a, int l, int lane, int wave) {
    const bf16* H = (const bf16*)(a.ws + WS_H); const int* IDS = (const int*)(a.ws + WS_IDS); const float* GATE = (const float*)(a.ws + WS_GATE);
    const unsigned char* PU = a.ws + WS_PU + (size_t)l * NE * D; const unsigned char* PV = a.ws + WS_PV + (size_t)l * NE * D;
    const float* DSU = (const float*)(a.ws + WS_DS) + (size_t)l * NE; const float* DSV = (const float*)(a.ws + WS_DS) + (size_t)(DEPTH + l) * NE;
    const float* modv = (const float*)(a.ws + WS_MOD);
    const int gw = blockIdx.x * NWAVES + wave, NGW = gridDim.x * NWAVES;
    for (int t = gw; t < M; t += NGW) {
        const int b = t / SEQ;
        float hv[32];
#pragma unroll
        for (int i = 0; i < 2; ++i)
#pragma unroll
            for (int hf = 0; hf < 2; ++hf) { const v4u w = *(const v4u*)(H + (size_t)t * D + 1024 * i + 16 * lane + 8 * hf);
#pragma unroll
                for (int k = 0; k < 4; ++k) { hv[16 * i + 8 * hf + 2 * k] = bf_lo(w[k]); hv[16 * i + 8 * hf + 2 * k + 1] = bf_hi(w[k]); } }
        v2u s0, s1; s0.x = (unsigned)IDS[(size_t)t * 128 + lane]; s1.x = (unsigned)IDS[(size_t)t * 128 + 64 + lane]; s0.y = __float_as_uint(GATE[(size_t)t * 128 + lane]); s1.y = __float_as_uint(GATE[(size_t)t * 128 + 64 + lane]);
        const float du0 = DSU[s0.x], du1 = DSU[s1.x], dv0 = DSV[s0.x], dv1 = DSV[s1.x];
        float out[32];
#pragma unroll
        for (int i = 0; i < 32; ++i) out[i] = 0.f;
#pragma unroll 1
        for (int grep_ = 0; grep_ < GATHER_REP; ++grep_) {
        asm volatile("" ::: "memory");
        float dsel0 = 0.f, dsel1 = 0.f;
#pragma unroll 1
        for (int grp = 0; grp < 16; ++grp) {
            const unsigned eme = (grp & 8) ? s1.x : s0.x; const int lb = (grp & 7) * 8;
            v4u uv[8][2];
#pragma unroll
            for (int q = 0; q < 8; ++q) { const unsigned e = (unsigned)__builtin_amdgcn_readlane((int)eme, lb + q); const unsigned char* urow = PU + (size_t)e * D + 16 * lane;
#pragma unroll
                for (int i = 0; i < 2; ++i) uv[q][i] = *(const v4u*)(urow + 1024 * i); }
            float part[8];
#pragma unroll
            for (int q = 0; q < 8; ++q) { float s = 0.f, s2 = 0.f;
#pragma unroll
                for (int i = 0; i < 2; ++i)
#pragma unroll
                    for (int k = 0; k < 4; ++k) { const f32x2 lo = __builtin_amdgcn_cvt_pk_f32_fp8((int)uv[q][i][k], false), hi = __builtin_amdgcn_cvt_pk_f32_fp8((int)uv[q][i][k], true);
                        s += lo.x * hv[16 * i + 4 * k]; s2 += lo.y * hv[16 * i + 4 * k + 1]; s += hi.x * hv[16 * i + 4 * k + 2]; s2 += hi.y * hv[16 * i + 4 * k + 3]; }
                part[q] = s + s2; }
#pragma unroll
            for (int o = 4; o >= 1; o >>= 1) {
                const bool up = (lane & o) != 0;
#pragma unroll
                for (int i = 0; i < o; ++i) { const float lo = part[i], hi = part[i + o]; const float send = up ? lo : hi, keep = up ? hi : lo; part[i] = keep + __shfl_xor(send, o); }
            }
            float tot = part[0]; tot += __shfl_xor(tot, 8); tot += __shfl_xor(tot, 16); tot += __shfl_xor(tot, 32);
            const bool mine = (lane >> 3) == (grp & 7);
            if (grp & 8) dsel1 = mine ? tot : dsel1; else dsel0 = mine ? tot : dsel0;
        }
        const float w0 = __uint_as_float(s0.y) * gelu1(dsel0 * du0) * dv0, w1 = __uint_as_float(s1.y) * gelu1(dsel1 * du1) * dv1;
#pragma unroll 1
        for (int grp = 0; grp < 16; ++grp) {
            const unsigned eme = (grp & 8) ? s1.x : s0.x; const unsigned wme = __float_as_uint((grp & 8) ? w1 : w0); const int lb = (grp & 7) * 8;
            v4u vv[8][2];
#pragma unroll
            for (int q = 0; q < 8; ++q) { const unsigned e = (unsigned)__builtin_amdgcn_readlane((int)eme, lb + q); const unsigned char* vrow = PV + (size_t)e * D + 16 * lane;
#pragma unroll
                for (int i = 0; i < 2; ++i) vv[q][i] = *(const v4u*)(vrow + 1024 * i); }
#pragma unroll
            for (int q = 0; q < 8; ++q) { const float w = __uint_as_float((unsigned)__builtin_amdgcn_readlane((int)wme, lb + q));
#pragma unroll
                for (int i = 0; i < 2; ++i)
#pragma unroll
                    for (int k = 0; k < 4; ++k) { const f32x2 lo = __builtin_amdgcn_cvt_pk_f32_fp8((int)vv[q][i][k], false), hi = __builtin_amdgcn_cvt_pk_f32_fp8((int)vv[q][i][k], true);
                        out[16 * i + 4 * k] += w * lo.x; out[16 * i + 4 * k + 1] += w * lo.y; out[16 * i + 4 * k + 2] += w * hi.x; out[16 * i + 4 * k + 3] += w * hi.y; }
                }
        }
        }
        if (GATHER_REP > 1) {
#pragma unroll
            for (int i = 0; i < 32; ++i) out[i] *= (1.0f / GATHER_REP); }
        int ln = lane; asm volatile("" : "+v"(ln));
        const float* xr = a.out + (size_t)t * D; const float* gf = modv + (size_t)(l * NB + b) * NMOD + 5 * D;
        float ssq = 0.f;
#pragma unroll
        for (int i = 0; i < 2; ++i)
#pragma unroll
            for (int q = 0; q < 4; ++q) { const int c = 1024 * i + 16 * ln + 4 * q; const f32x4 xv = *(const f32x4*)(xr + c), gv = *(const f32x4*)(gf + c);
#pragma unroll
                for (int k = 0; k < 4; ++k) { const float nv = xv[k] + gv[k] * out[16 * i + 4 * q + k]; out[16 * i + 4 * q + k] = nv; ssq += nv * nv; }
                if (q == 3) asm volatile("" ::: "memory"); }
        const float rstd = 1.0f / sqrtf(wave_sum(ssq) * (1.0f / D) + EPS);
        if (l + 1 < DEPTH) {
            const float* gain = a.in[4] + (size_t)(l + 1) * D; const float* mb = modv + (size_t)((l + 1) * NB + b) * NMOD;
            float* xw = a.out + (size_t)t * D; bf16* hw = (bf16*)(a.ws + WS_H) + (size_t)t * D;
#pragma unroll
            for (int i = 0; i < 2; ++i) { unsigned pk[8];
#pragma unroll
                for (int q = 0; q < 4; ++q) { const int c = 1024 * i + 16 * ln + 4 * q; const f32x4 gn = *(const f32x4*)(gain + c), scv = *(const f32x4*)(mb + D + c), shv = *(const f32x4*)(mb + c);
                    f32x4 nv = (f32x4){out[16 * i + 4 * q], out[16 * i + 4 * q + 1], out[16 * i + 4 * q + 2], out[16 * i + 4 * q + 3]};
                    *(f32x4*)(xw + c) = nv; const f32x4 o = nv * rstd * gn * (scv + 1.0f) + shv; pk[2 * q] = cvt_pk_bf16(o[0], o[1]); pk[2 * q + 1] = cvt_pk_bf16(o[2], o[3]);
                    if (q & 1) asm volatile("" ::: "memory"); }
                *(v4u*)(hw + 1024 * i + 16 * ln) = (v4u){pk[0], pk[1], pk[2], pk[3]}; *(v4u*)(hw + 1024 * i + 16 * ln + 8) = (v4u){pk[4], pk[5], pk[6], pk[7]}; }
        } else {
            const float* gain = a.in[23]; float* xw = a.out + (size_t)t * D;
#pragma unroll
            for (int i = 0; i < 2; ++i)
#pragma unroll
                for (int q = 0; q < 4; ++q) { const int c = 1024 * i + 16 * ln + 4 * q; const f32x4 gn = *(const f32x4*)(gain + c);
                    const f32x4 nv = (f32x4){out[16 * i + 4 * q], out[16 * i + 4 * q + 1], out[16 * i + 4 * q + 2], out[16 * i + 4 * q + 3]}; *(f32x4*)(xw + c) = nv * rstd * gn; }
        }
    }
}

__device__ __forceinline__ bool peer_item(const PeerMap& pm, int k, int& s, int& tb) {
    if (pm.fast) { if (k >= 8) return false; s = 2 * pm.x + (k >> 2); tb = pm.r + 32 * (k & 3); return true; }
    const int it = blockIdx.x + k * gridDim.x; if (it >= 2048) return false; s = it >> 7; tb = it & 127; return true;
}
#define PU_IDS(ID, t_) do { const v4u* idp_ = (const v4u*)(IDS16 + (size_t)(t_) * 128 + 16 * rg); ID[0] = idp_[0]; ID[1] = idp_[1]; } while (0)
#define PU_ROWS(RV, ID, base_) do { _Pragma("unroll") for (int j_ = 0; j_ < 16; ++j_) { const unsigned w_ = ID[j_ >> 3][(j_ >> 1) & 3]; const unsigned e_ = (j_ & 1) ? (w_ >> 16) : (w_ & 0xffffu); \
        RV[j_] = *(const v4u*)((base_) + (e_ * 128u + co)); } } while (0)
#define PU_H(HR, t_) do { HR = *(const v4u*)(HQ + (size_t)(t_) * D + s * 128 + co); } while (0)
#define PU_COMPUTE(RV, HR, t_) do { int part[16]; \
        _Pragma("unroll") for (int j = 0; j < 16; ++j) { int s_ = __builtin_amdgcn_sdot4((int)RV[j].x, (int)HR.x, 0, false); s_ = __builtin_amdgcn_sdot4((int)RV[j].y, (int)HR.y, s_, false); \
            s_ = __builtin_amdgcn_sdot4((int)RV[j].z, (int)HR.z, s_, false); part[j] = __builtin_amdgcn_sdot4((int)RV[j].w, (int)HR.w, s_, false); } \
        _Pragma("unroll") for (int o = 4, n = 8; o >= 1; o >>= 1, n >>= 1) { const bool up = (ln & o) != 0; \
            _Pragma("unroll") for (int q = 0; q < n; ++q) { const int lo = part[q], hi = part[q + n]; const int send = up ? lo : hi, keep = up ? hi : lo; part[q] = keep + __shfl_xor(send, o); } } \
        P[((size_t)s * M + (t_)) * 64 + 8 * rg + c8] = cvt_pk_bf16((float)part[0], (float)part[1]); } while (0)
__device__ __forceinline__ void peer_u_phase(const Args& a, int l, const PeerMap& pm, int lane, int wave) {
    const unsigned char* HQ = a.ws + WS_HQ; const unsigned short* IDS16 = (const unsigned short*)(a.ws + WS_IDS16); unsigned* P = (unsigned*)(a.ws + WS_P);
    const unsigned char* PU = a.ws + WS_PU + (size_t)l * NE * D;
    int s, tb;
#pragma unroll 1
    for (int k_ = 0; peer_item(pm, k_, s, tb); ++k_) {
        int ln = lane; asm volatile("" : "+v"(ln)); const int c8 = ln & 7, rg = ln >> 3; const unsigned co = 16u * (unsigned)c8;
        const unsigned char* ub = PU + (size_t)s * NE * 128; const int t0 = tb * 128 + wave * 16;
        v4u id[2], rvA[16], rvB[16], hA, hB;
        PU_IDS(id, t0); PU_H(hA, t0); PU_ROWS(rvA, id, ub); PU_IDS(id, t0 + 1); PU_H(hB, t0 + 1);
#pragma unroll 1
        for (int i = 0; i < 16; i += 2) {
            const int t2 = t0 + (i + 2 < 16 ? i + 2 : 15), t3 = t0 + (i + 3 < 16 ? i + 3 : 15);
            PU_ROWS(rvB, id, ub); PU_IDS(id, t2);
            PU_COMPUTE(rvA, hA, t0 + i);
            PU_H(hA, t2); PU_ROWS(rvA, id, ub); PU_IDS(id, t3);
            PU_COMPUTE(rvB, hB, t0 + i + 1);
            PU_H(hB, t3);
        }
    }
}
__device__ __forceinline__ void peer_act_phase(const Args& a, int l, int lane, int wave) {
    const unsigned* P = (const unsigned*)(a.ws + WS_P); const int* IDS = (const int*)(a.ws + WS_IDS); const float* GATE = (const float*)(a.ws + WS_GATE);
    const float* DSU = (const float*)(a.ws + WS_DS) + (size_t)l * NE; const float* DSV = (const float*)(a.ws + WS_DS) + (size_t)(DEPTH + l) * NE; const float* HQS = (const float*)(a.ws + WS_HQS);
    unsigned* WQ8 = (unsigned*)(a.ws + WS_WQ8); float* WS = (float*)(a.ws + WS_WS);
    const int gw = blockIdx.x * NWAVES + wave, NGW = gridDim.x * NWAVES;
    for (int tp = gw; tp < M / 2; tp += NGW) {
        const int t = 2 * tp + (lane >> 5); const size_t i = (size_t)t * 128 + 4 * (lane & 31);
        v2u sv[16];
#pragma unroll
        for (int sl = 0; sl < 16; ++sl) sv[sl] = *(const v2u*)(P + ((size_t)sl * M * 128 + i) / 2);
        const v4u e = *(const v4u*)(IDS + i); const f32x4 g = *(const f32x4*)(GATE + i); const float hs = HQS[t];
        f32x4 s = (f32x4){0.f, 0.f, 0.f, 0.f};
#pragma unroll
        for (int sl = 0; sl < 16; ++sl) { s[0] += bf_lo(sv[sl].x); s[1] += bf_hi(sv[sl].x); s[2] += bf_lo(sv[sl].y); s[3] += bf_hi(sv[sl].y); }
        f32x4 w; float mx = 0.f;
#pragma unroll
        for (int k = 0; k < 4; ++k) { w[k] = g[k] * gelu1(s[k] * hs * DSU[e[k]]) * DSV[e[k]]; mx = fmaxf(mx, fabsf(w[k])); }
#pragma unroll
        for (int o = 1; o < 32; o <<= 1) mx = fmaxf(mx, __shfl_xor(mx, o));
        const float q = mx > 0.f ? 127.0f / mx : 1.0f;
        WQ8[i >> 2] = pack_i8(w[0] * q, w[1] * q, w[2] * q, w[3] * q);
        if ((lane & 31) == 0) WS[t] = mx > 0.f ? mx * (1.0f / 127.0f) : 1.0f;
    }
}
#define PV_W(WR, t_) do { WR = *(const v4u*)(WQ8 + (size_t)(t_) * 128 + 16 * rg); } while (0)
#define PV_COMPUTE(RV, WR, t_) do { int o16[16]; \
        _Pragma("unroll") for (int k = 0; k < 16; ++k) o16[k] = 0; \
        _Pragma("unroll") for (int g_ = 0; g_ < 4; ++g_) { const int wg_ = (int)WR[g_]; \
            _Pragma("unroll") for (int c_ = 0; c_ < 4; ++c_) { const unsigned ra = RV[4 * g_][c_], rb = RV[4 * g_ + 1][c_], rc = RV[4 * g_ + 2][c_], rd = RV[4 * g_ + 3][c_]; \
                const unsigned x0 = __builtin_amdgcn_perm(rb, ra, 0x05010400u), x1 = __builtin_amdgcn_perm(rb, ra, 0x07030602u), y0 = __builtin_amdgcn_perm(rd, rc, 0x05010400u), y1 = __builtin_amdgcn_perm(rd, rc, 0x07030602u); \
                o16[4 * c_ + 0] = __builtin_amdgcn_sdot4((int)__builtin_amdgcn_perm(y0, x0, 0x05040100u), wg_, o16[4 * c_ + 0], false); \
                o16[4 * c_ + 1] = __builtin_amdgcn_sdot4((int)__builtin_amdgcn_perm(y0, x0, 0x07060302u), wg_, o16[4 * c_ + 1], false); \
                o16[4 * c_ + 2] = __builtin_amdgcn_sdot4((int)__builtin_amdgcn_perm(y1, x1, 0x05040100u), wg_, o16[4 * c_ + 2], false); \
                o16[4 * c_ + 3] = __builtin_amdgcn_sdot4((int)__builtin_amdgcn_perm(y1, x1, 0x07060302u), wg_, o16[4 * c_ + 3], false); } } \
        _Pragma("unroll") for (int o = 32, n = 8; o >= 8; o >>= 1, n >>= 1) { const bool up = (ln & o) != 0; \
            _Pragma("unroll") for (int q = 0; q < n; ++q) { const int lo = o16[q], hi = o16[q + n]; const int send = up ? lo : hi, keep = up ? hi : lo; o16[q] = keep + __shfl_xor(send, o); } } \
        const int col = s * 128 + 16 * c8 + 2 * rg; const float ws_ = WS[(t_)]; \
        unsigned* xp = (unsigned*)(XB + (size_t)(t_) * D + col); const unsigned xv = *xp; const f32x2 gv = *(const f32x2*)(modv + (size_t)(l * NB + (t_) / SEQ) * NMOD + 5 * D + col); \
        *xp = cvt_pk_bf16(bf_lo(xv) + gv.x * (ws_ * (float)o16[0]), bf_hi(xv) + gv.y * (ws_ * (float)o16[1])); } while (0)
__device__ __forceinline__ void peer_v_phase(const Args& a, int l, const PeerMap& pm, int lane, int wave) {
    const unsigned short* IDS16 = (const unsigned short*)(a.ws + WS_IDS16); const unsigned char* WQ8 = a.ws + WS_WQ8; const float* WS = (const float*)(a.ws + WS_WS);
    const unsigned char* PV = a.ws + WS_PV + (size_t)l * NE * D; const float* modv = (const float*)(a.ws + WS_MOD); bf16* XB = (bf16*)(a.ws + WS_XB);
    int s, tb;
#pragma unroll 1
    for (int k_ = 0; peer_item(pm, k_, s, tb); ++k_) {
        int ln = lane; asm volatile("" : "+v"(ln)); const int c8 = ln & 7, rg = ln >> 3; const unsigned co = 16u * (unsigned)c8;
        const unsigned char* vb = PV + (size_t)s * NE * 128; const int t0 = tb * 128 + wave * 16;
        v4u id[2], rvA[16], rvB[16], wA, wB;
        PU_IDS(id, t0); PV_W(wA, t0); PU_ROWS(rvA, id, vb); PU_IDS(id, t0 + 1); PV_W(wB, t0 + 1);
#pragma unroll 1
        for (int i = 0; i < 16; i += 2) {
            const int t2 = t0 + (i + 2 < 16 ? i + 2 : 15), t3 = t0 + (i + 3 < 16 ? i + 3 : 15);
            PU_ROWS(rvB, id, vb); PU_IDS(id, t2);
            PV_COMPUTE(rvA, wA, t0 + i);
            PV_W(wA, t2); PU_ROWS(rvA, id, vb); PU_IDS(id, t3);
            PV_COMPUTE(rvB, wB, t0 + i + 1);
            PV_W(wB, t3);
        }
    }
}
__device__ __forceinline__ void peer_norm_phase(const Args& a, int l, int lane, int wave) {
    const int gw = blockIdx.x * NWAVES + wave, NGW = gridDim.x * NWAVES; const float* modv = (const float*)(a.ws + WS_MOD); const bf16* XB = (const bf16*)(a.ws + WS_XB);
    if (l + 1 < DEPTH) { for (int m = gw; m < M; m += NGW) { const float* mb = modv + (size_t)((l + 1) * NB + m / SEQ) * NMOD; modnorm_row<3, true>(XB + (size_t)m * D, a.in[4] + (size_t)(l + 1) * D, mb + D, mb, nullptr, lane, a.ws + WS_H8 + (size_t)m * D, (float*)(a.ws + WS_HS) + m); } }
    else { for (int m = gw; m < M; m += NGW) { const bf16* xrow = XB + (size_t)m * D; float* orow = a.out + (size_t)m * D; f32x4 v[8]; float s = 0.f;
#pragma unroll
            for (int j = 0; j < 8; ++j) { const v2u w = *(const v2u*)(xrow + 4 * lane + 256 * j); v[j] = (f32x4){bf_lo(w.x), bf_hi(w.x), bf_lo(w.y), bf_hi(w.y)}; s += (v[j][0] * v[j][0] + v[j][1] * v[j][1]) + (v[j][2] * v[j][2] + v[j][3] * v[j][3]); }
            const float rstd = 1.0f / sqrtf(wave_sum(s) * (1.0f / D) + EPS);
#pragma unroll
            for (int j = 0; j < 8; ++j) { const f32x4 gn = *(const f32x4*)(a.in[23] + 4 * lane + 256 * j); *(f32x4*)(orow + 4 * lane + 256 * j) = v[j] * rstd * gn; } } }
}

__device__ __forceinline__ void peer_fused_phase(const Args& a, LAS unsigned char* lds, int l, int, int wave) {
#define PF_WS() GAS unsigned char* wsg_ = (GAS unsigned char*)a.ws; asm volatile("" : "+s"(wsg_)); unsigned char* ws_ = (unsigned char*)wsg_
#if !PEER_VMFMA
    { int tid2 = threadIdx.x; asm volatile("" : "+v"(tid2)); topk_phase(a, lds, l, tid2, tid2 & 63, wave, 0, 0, 1, true); }
#endif
    for (int tb = blockIdx.x; tb < M / 64; tb += gridDim.x) {
#if PEER_VMFMA
        __syncthreads();
        { int tid2 = threadIdx.x; asm volatile("" : "+v"(tid2)); topk_phase(a, lds, l, tid2, tid2 & 63, wave, 0, 0, 1, true); }
#endif
#if PEER_VMFMA
        LAS unsigned short* ids_l = (LAS unsigned short*)(lds + 8 * 16640);
        { int tid2 = threadIdx.x; asm volatile("" : "+v"(tid2)); topk_phase(a, lds, l, tid2, tid2 & 63, wave, tb * 16 + wave, tb * 16 + 16, 8, false, ids_l, tb * 64); }
#define PF_IDS(ID, t_) do { const LAS v4u* idp_ = (const LAS v4u*)(ids_l + ((t_) - tb * 64) * 128 + 16 * rg); ID[0] = idp_[0]; ID[1] = idp_[1]; } while (0)
#else
        { int tid2 = threadIdx.x; asm volatile("" : "+v"(tid2)); topk_phase(a, lds, l, tid2, tid2 & 63, wave, tb * 16 + wave, tb * 16 + 16, 8, false); }
#define PF_IDS(ID, t_) PU_IDS(ID, t_)
#endif
        __builtin_amdgcn_fence(__ATOMIC_RELEASE, "workgroup"); __syncthreads(); __builtin_amdgcn_fence(__ATOMIC_ACQUIRE, "workgroup");
        int ln = threadIdx.x & 63; asm volatile("" : "+v"(ln)); const int c8 = ln & 7, rg = ln >> 3; const unsigned co = 16u * (unsigned)c8;
#if PEER_VMFMA
        LAS unsigned char* wq_l = lds + 8 * 16640 + 16384 + wave * 1056;
        LAS unsigned char* vbuf = lds + wave * 16640;
        LAS unsigned char* accb = vbuf + ln * 8;
#else
        LAS unsigned char* accb = lds + 81920 + wave * 4096 + ln * 8;
#endif
        const int t0 = tb * 64 + wave * 8;
#define PF_XCH(v_, o_) ((o_) == 4 ? __builtin_amdgcn_update_dpp(0, (v_), 0x141, 0xf, 0xf, false) : (o_) == 2 ? __builtin_amdgcn_update_dpp(0, (v_), 0x4e, 0xf, 0xf, false) : __builtin_amdgcn_update_dpp(0, (v_), 0xb1, 0xf, 0xf, false))
#define PF_UCOMPUTE(RV, HR, i_) do { int part[16]; \
        _Pragma("unroll") for (int j = 0; j < 16; ++j) { int s_ = __builtin_amdgcn_sdot4((int)RV[j].x, (int)HR.x, 0, false); s_ = __builtin_amdgcn_sdot4((int)RV[j].y, (int)HR.y, s_, false); \
            s_ = __builtin_amdgcn_sdot4((int)RV[j].z, (int)HR.z, s_, false); part[j] = __builtin_amdgcn_sdot4((int)RV[j].w, (int)HR.w, s_, false); } \
        _Pragma("unroll") for (int o = 4, n = 8; o >= 1; o >>= 1, n >>= 1) { const bool up = (ln & o) != 0; \
            _Pragma("unroll") for (int q = 0; q < n; ++q) { const int lo = part[q], hi = part[q + n]; const int send = up ? lo : hi, keep = up ? hi : lo; part[q] = keep + PF_XCH(send, o); } } \
        LAS v2u* ap_ = (LAS v2u*)(accb + (i_) * 512); v2u av_ = s ? *ap_ : (v2u){0u, 0u}; av_.x += (unsigned)part[0]; av_.y += (unsigned)part[1]; *ap_ = av_; } while (0)
        { PF_WS(); const unsigned char* HQ = ws_ + WS_HQ; const unsigned short* IDS16 = (const unsigned short*)(ws_ + WS_IDS16); const unsigned char* PU = ws_ + WS_PU + (size_t)l * NE * D;
#if PEER_VMFMA
        LAS unsigned char* hbuf = vbuf + 4096;
#define PF_HT_LOAD(REG, s_) do { REG = __builtin_nontemporal_load((const v4u*)(HQ + (size_t)(t0 + rg) * D + (s_) * 128 + co)); } while (0)
#define PF_HT_PUT(REG, s_) do { *(LAS v4u*)(hbuf + ((s_) & 1) * 1024 + rg * 128 + co) = REG; } while (0)
#define PF_H(HR, q_) do { HR = *(const LAS v4u*)(hbuf + (((q_) >> 3) & 1) * 1024 + ((q_) & 7) * 128 + co); } while (0)
#else
#define PF_H(HR, q_) do { HR = __builtin_nontemporal_load((const v4u*)(HQ + (size_t)(t0 + ((q_) & 7)) * D + ((q_) >> 3) * 128 + co)); } while (0)
#endif
#define PF_UB(q_) (PU + (size_t)((q_) >> 3) * NE * 128)
        {
            {
            const bool defer = PEER_DEFER && (l + 1 < DEPTH) && (tb == (int)blockIdx.x); const int qs1 = defer ? 8 * wave : 0, qs2 = defer ? 64 + 8 * wave : 0;
#pragma unroll 1
            for (int seg = 0; seg < 3; ++seg) {
            const int qa = seg == 0 ? 0 : seg == 1 ? qs1 : qs2, qb = seg == 0 ? qs1 : seg == 1 ? qs2 : 128;
            if (qa < qb) {
            v4u idA[2], idB[2], rvA[16], rvB[16], hA, hB;
#if PEER_VMFMA
            v4u ht; { const int sa_ = qa >> 3; PF_HT_LOAD(ht, sa_); PF_HT_PUT(ht, sa_); PF_HT_LOAD(ht, sa_ + 1 < 16 ? sa_ + 1 : 15); }
#endif
            PF_IDS(idA, t0 + (qa & 7)); PF_IDS(idB, t0 + ((qa + 1) & 7)); PF_H(hA, qa); PF_H(hB, qa + 1); PU_ROWS(rvA, idA, PF_UB(qa)); PF_IDS(idA, t0 + ((qa + 2 < qb ? qa + 2 : qb - 1) & 7));
#pragma unroll 1
            for (int q = qa; q < qb; q += 2) {
                const int q2 = q + 2 < qb ? q + 2 : qb - 1, q3 = q + 3 < qb ? q + 3 : qb - 1, q4 = q + 4 < qb ? q + 4 : qb - 1;
#if PEER_VMFMA
                if ((q & 7) == 4) { const int s1_ = (q >> 3) + 1 < 16 ? (q >> 3) + 1 : 15, s2_ = (q >> 3) + 2 < 16 ? (q >> 3) + 2 : 15; PF_HT_PUT(ht, s1_); PF_HT_LOAD(ht, s2_); }
#endif
                PU_ROWS(rvB, idB, PF_UB(q + 1)); PF_IDS(idB, t0 + (q3 & 7));
                { const int s = q >> 3; PF_UCOMPUTE(rvA, hA, q & 7); }
                PF_H(hA, q2); PU_ROWS(rvA, idA, PF_UB(q2)); PF_IDS(idA, t0 + (q4 & 7));
                { const int s = (q + 1) >> 3; PF_UCOMPUTE(rvB, hB, (q + 1) & 7); }
                PF_H(hB, q3);
            }
            }
            if (seg < 2 && defer) {
                Args a2 = a; a2.ws = ws_;
                const int gw = blockIdx.x * NWAVES + wave, NGW = gridDim.x * NWAVES;
                for (int c = gw; c < 2 * NE / 16; c += NGW)
#pragma unroll 1
                    for (int i = 8 * seg; i < 8 * seg + 8; i += 2) { const int rr = c * 16 + i, tab = rr >= NE; peer_conv_row2(a2, tab, (l + 1) * NE + rr - tab * NE, ln); }
            }
            }
            }
        }
#undef PF_H
#undef PF_HT_LOAD
#undef PF_HT_PUT
#undef PF_UB
        }
        { PF_WS(); const int* IDS = (const int*)(ws_ + WS_IDS); const float* GATE = (const float*)(ws_ + WS_GATE); const float* DSU = (const float*)(ws_ + WS_DS) + (size_t)l * NE; const float* DSV = (const float*)(ws_ + WS_DS) + (size_t)(DEPTH + l) * NE;
          const float* HQS = (const float*)(ws_ + WS_HQS); unsigned char* WQ8 = ws_ + WS_WQ8; float* WS = (float*)(ws_ + WS_WS);
          { v2u av[8], e[8]; f32x2 g[8]; float hs[8], du0[8], du1[8], dv0[8], dv1[8];
            const size_t kb0 = (size_t)t0 * 128 + 16 * rg + 2 * c8;
#pragma unroll
            for (int i = 0; i < 8; ++i) { av[i] = *(const LAS v2u*)(accb + i * 512); e[i] = *(const v2u*)(IDS + kb0 + 128 * i); g[i] = *(const f32x2*)(GATE + kb0 + 128 * i); hs[i] = HQS[t0 + i]; }
#pragma unroll
            for (int i = 0; i < 8; ++i) { du0[i] = DSU[e[i].x]; du1[i] = DSU[e[i].y]; dv0[i] = DSV[e[i].x]; dv1[i] = DSV[e[i].y]; }
#pragma unroll
            for (int i = 0; i < 8; ++i) {
                const float w0 = g[i].x * gelu1((float)(int)av[i].x * hs[i] * du0[i]) * dv0[i], w1 = g[i].y * gelu1((float)(int)av[i].y * hs[i] * du1[i]) * dv1[i];
                float mx = fmaxf(fabsf(w0), fabsf(w1));
#pragma unroll
                for (int o = 1; o < 64; o <<= 1) mx = fmaxf(mx, __shfl_xor(mx, o));
                const float q = mx > 0.f ? 127.0f / mx : 1.0f;
                const int i0 = (int)rintf(w0 * q), i1 = (int)rintf(w1 * q);
#if PEER_VMFMA
                *(LAS unsigned short*)(wq_l + i * 128 + 16 * rg + 2 * c8) = (unsigned short)(((unsigned)i0 & 255u) | (((unsigned)i1 & 255u) << 8));
                if (ln == 0) *(LAS float*)(wq_l + 1024 + 4 * i) = mx > 0.f ? mx * (1.0f / 127.0f) : 1.0f; }
#else
                *(unsigned short*)(WQ8 + kb0 + 128 * i) = (unsigned short)(((unsigned)i0 & 255u) | (((unsigned)i1 & 255u) << 8));
                if (ln == 0) WS[t0 + i] = mx > 0.f ? mx * (1.0f / 127.0f) : 1.0f; }
#endif
          }
        }
        __builtin_amdgcn_fence(__ATOMIC_RELEASE, "workgroup"); asm volatile("s_waitcnt vmcnt(0)" ::: "memory"); __builtin_amdgcn_fence(__ATOMIC_ACQUIRE, "workgroup");
        { PF_WS(); const unsigned short* IDS16 = (const unsigned short*)(ws_ + WS_IDS16); const unsigned char* PV = ws_ + WS_PV + (size_t)l * NE * D; const unsigned char* WQ8 = ws_ + WS_WQ8; const float* WS = (const float*)(ws_ + WS_WS);
          const float* modv = (const float*)(ws_ + WS_MOD); bf16* XB = (bf16*)(ws_ + WS_XB);
#define PF_VB(q_) (PV + (size_t)((q_) >> 3) * NE * 128)
        {
#if PEER_VMFMA
            typedef int v4i_ __attribute__((ext_vector_type(4))); typedef int v2i_ __attribute__((ext_vector_type(2)));
            const int g4 = ln >> 4, i16 = ln & 15;
            LAS unsigned char* vwr = vbuf + ln * 16; LAS unsigned char* vrd = vbuf + (i16 >> 1) * 1040 + g4 * 128 + 8 * (i16 & 1);
#define PV2_W(WR, XV, GV, SF, t_, s_) do { const LAS unsigned char* wp_ = wq_l + ((t_) - t0) * 128 + 16 * g4; WR[0] = *(const LAS v4u*)wp_; WR[1] = *(const LAS v4u*)(wp_ + 64);     \
        const int col_ = (s_) * 128 + ocol; XV = __builtin_nontemporal_load((const unsigned*)(XB + (size_t)(t_) * D + col_)); SF = *(const LAS float*)(wq_l + 1024 + 4 * ((t_) - t0)) * vscale_; } while (0)
#if XB_NT_ST
#define PV2_ST(v, p) __builtin_nontemporal_store((v), (p))
#else
#define PV2_ST(v, p) (*(p) = (v))
#endif
#define PV2_PUT(RV) do { asm volatile("" ::: "memory"); \
        _Pragma("unroll") for (int j_ = 0; j_ < 16; ++j_) *(LAS v4u*)(vwr + j_ * 1040) = RV[j_]; asm volatile("" ::: "memory"); } while (0)
#define PV2_MMA(WR, XV, GV, SF, t_, s_) do { \
        int o8[8]; \
        _Pragma("unroll") for (int nb_ = 0; nb_ < 8; ++nb_) { v4i_ acc_ = (v4i_){0, 0, 0, 0}; \
            _Pragma("unroll") for (int kh_ = 0; kh_ < 2; ++kh_) { \
                const v2i_ b0_ = __builtin_amdgcn_ds_read_tr8_b64_v2i32((LAS v2i_*)(vrd + kh_ * 512 + nb_ * 16)), b1_ = __builtin_amdgcn_ds_read_tr8_b64_v2i32((LAS v2i_*)(vrd + 8320 + kh_ * 512 + nb_ * 16)); \
                acc_ = __builtin_amdgcn_mfma_i32_16x16x64_i8((v4i_){(int)WR[kh_].x, (int)WR[kh_].y, (int)WR[kh_].z, (int)WR[kh_].w}, (v4i_){b0_.x, b0_.y, b1_.x, b1_.y}, acc_, 0, 0, 0); } \
            o8[nb_] = acc_[0]; } \
        asm volatile("" ::: "memory"); \
        const int p0_ = gb1 ? (gb0 ? o8[6] : o8[4]) : (gb0 ? o8[2] : o8[0]), p1_ = gb1 ? (gb0 ? o8[7] : o8[5]) : (gb0 ? o8[3] : o8[1]); \
        const int rcv_ = __builtin_amdgcn_update_dpp(0, odd ? p0_ : p1_, 0xb1, 0xf, 0xf, false); const int lo_ = odd ? rcv_ : p0_, hi_ = odd ? p1_ : rcv_; \
        PV2_ST(cvt_pk_bf16(bf_lo(XV) + GV.x * (SF * (float)lo_), bf_hi(XV) + GV.y * (SF * (float)hi_)), (unsigned*)(XB + (size_t)(t_) * D + (s_) * 128 + ocol)); } while (0)
            const bool gb0 = (g4 & 1) != 0, gb1 = (g4 & 2) != 0, odd = (i16 & 1) != 0; const int ocol = 32 * g4 + 16 * (i16 & 1) + (i16 & 14);
#ifdef PF_VREP
#pragma unroll 1
            for (int vrep_ = 0; vrep_ < PF_VREP; ++vrep_) { const float vscale_ = vrep_ == PF_VREP - 1 ? 1.0f : 0.0f;
            if (vrep_) { __builtin_amdgcn_fence(__ATOMIC_RELEASE, "workgroup"); asm volatile("s_waitcnt vmcnt(0)" ::: "memory"); __builtin_amdgcn_fence(__ATOMIC_ACQUIRE, "workgroup"); }
#else
            { const float vscale_ = 1.0f;
#endif
            v4u idA[2], idB[2], rvA[16], rvB[16], wA[2], wB[2]; unsigned xA, xB; float sA, sB;
            const float* gvp = modv + (size_t)(l * NB + t0 / SEQ) * NMOD + 5 * D + ocol;
            f32x2 gA = *(const f32x2*)gvp, gN = *(const f32x2*)(gvp + 128);
#define gB gA
            PF_IDS(idA, t0); PF_IDS(idB, t0 + 1); PV2_W(wA, xA, gA, sA, t0, 0); PV2_W(wB, xB, gB, sB, t0 + 1, 0);
            PU_ROWS(rvA, idA, PF_VB(0)); PU_ROWS(rvB, idB, PF_VB(1)); PF_IDS(idA, t0 + 2); PF_IDS(idB, t0 + 3);
#pragma unroll 1
            for (int q = 0; q < 128; q += 2) {
                const int q2 = q + 2 < 128 ? q + 2 : 127, q3 = q + 3 < 128 ? q + 3 : 127, q4 = q + 4 < 128 ? q + 4 : 127, q5 = q + 5 < 128 ? q + 5 : 127;
                if ((q & 7) == 0 && q) { gA = gN; const int sn_ = (q >> 3) + 1 < 16 ? (q >> 3) + 1 : 15; gN = *(const f32x2*)(gvp + 128 * sn_); }
                PV2_PUT(rvA); PU_ROWS(rvA, idA, PF_VB(q2)); PF_IDS(idA, t0 + (q4 & 7));
                PV2_MMA(wA, xA, gA, sA, t0 + (q & 7), q >> 3);
                PV2_W(wA, xA, gA, sA, t0 + (q2 & 7), q2 >> 3);
                PV2_PUT(rvB); PU_ROWS(rvB, idB, PF_VB(q3)); PF_IDS(idB, t0 + (q5 & 7));
                PV2_MMA(wB, xB, gB, sB, t0 + ((q + 1) & 7), (q + 1) >> 3);
                PV2_W(wB, xB, gB, sB, t0 + (q3 & 7), q3 >> 3);
            }
            }
#undef gB
#undef PV2_PUT
#undef PV2_MMA
#undef PV2_W
#else
            v4u id[2], rvA[16], rvB[16], wA, wB;
            PF_IDS(id, t0); PV_W(wA, t0); PU_ROWS(rvA, id, PF_VB(0)); PF_IDS(id, t0 + 1); PV_W(wB, t0 + 1);
#pragma unroll 1
            for (int q = 0; q < 128; q += 2) {
                const int q2 = q + 2 < 128 ? q + 2 : 127, q3 = q + 3 < 128 ? q + 3 : 127;
                PU_ROWS(rvB, id, PF_VB(q + 1)); PF_IDS(id, t0 + (q2 & 7));
                { const int s = q >> 3; PV_COMPUTE(rvA, wA, t0 + (q & 7)); }
                PV_W(wA, t0 + (q2 & 7)); PU_ROWS(rvA, id, PF_VB(q2)); PF_IDS(id, t0 + (q3 & 7));
                { const int s = (q + 1) >> 3; PV_COMPUTE(rvB, wB, t0 + ((q + 1) & 7)); }
                PV_W(wB, t0 + (q3 & 7));
            }
#endif
        }
#undef PF_VB
        }
        __builtin_amdgcn_fence(__ATOMIC_RELEASE, "workgroup"); asm volatile("s_waitcnt vmcnt(0)" ::: "memory"); __builtin_amdgcn_fence(__ATOMIC_ACQUIRE, "workgroup");
        { PF_WS(); const float* modv = (const float*)(ws_ + WS_MOD); const bf16* XB = (const bf16*)(ws_ + WS_XB);
        { int lane = threadIdx.x & 63; asm volatile("" : "+v"(lane));
          v2u xr[8], xn[8];
#pragma unroll
          for (int j = 0; j < 8; ++j) xr[j] = *(const v2u*)(XB + (size_t)t0 * D + 4 * lane + 256 * j);
          f32x4 gs[8], shv[8];
          if (l + 1 < DEPTH) { const float* mb = modv + (size_t)((l + 1) * NB + t0 / SEQ) * NMOD; const float* gain = a.in[4] + (size_t)(l + 1) * D;
#pragma unroll
              for (int j = 0; j < 8; ++j) { const int c = 4 * lane + 256 * j; gs[j] = *(const f32x4*)(gain + c) * (*(const f32x4*)(mb + D + c) + 1.0f); shv[j] = *(const f32x4*)(mb + c); } }
          else {
#pragma unroll
              for (int j = 0; j < 8; ++j) { gs[j] = *(const f32x4*)(a.in[23] + 4 * lane + 256 * j); shv[j] = (f32x4){0.f, 0.f, 0.f, 0.f}; } }
#pragma unroll 1
          for (int i = 0; i < 8; ++i) {
            const int m = t0 + i, mn = t0 + (i + 1 < 8 ? i + 1 : 7);
#pragma unroll
            for (int j = 0; j < 8; ++j) xn[j] = *(const v2u*)(XB + (size_t)mn * D + 4 * lane + 256 * j);
            if (l + 1 < DEPTH) modnorm_pre(xr, gs, shv, lane, ws_ + WS_H8 + (size_t)m * D, (float*)(ws_ + WS_HS) + m);
            else { float* orow = a.out + (size_t)m * D; f32x4 v[8]; float sq = 0.f;
#pragma unroll
                for (int j = 0; j < 8; ++j) { const v2u w = xr[j]; v[j] = (f32x4){bf_lo(w.x), bf_hi(w.x), bf_lo(w.y), bf_hi(w.y)}; sq += (v[j][0] * v[j][0] + v[j][1] * v[j][1]) + (v[j][2] * v[j][2] + v[j][3] * v[j][3]); }
                const float rstd = 1.0f / sqrtf(wave_sum(sq) * (1.0f / D) + EPS);
#pragma unroll
                for (int j = 0; j < 8; ++j) *(f32x4*)(orow + 4 * lane + 256 * j) = v[j] * rstd * gs[j]; }
#pragma unroll
            for (int j = 0; j < 8; ++j) xr[j] = xn[j];
          } }
        }
#undef PF_UCOMPUTE
#undef PF_XCH
#undef PF_IDS
#undef PF_WS
    }
}
#ifndef GATHER_V2
#define GATHER_V2 1
#endif
#ifndef PEER_FUSED
#define PEER_FUSED 1
#endif
constexpr int PPL = PEER_FUSED ? 8 : (GATHER_V2 ? 12 : 9);
constexpr int NPH = 2 + PPL * DEPTH;
#ifndef PH_MASK
#define PH_MASK 0xFFFF
#endif
#define HAS(k) (((PH_MASK) >> (k)) & 1)
#ifndef REP_MASK
#define REP_MASK 0
#endif
#define REPEAT(k) _Pragma("unroll 1") for (int rep_ = 0; rep_ < ((((REP_MASK) >> (k)) & 1) + 1); ++rep_)
#ifndef MK_PER_PHASE
#define MK_PER_PHASE 0
#endif
typedef const __attribute__((address_space(4))) Args* KArgs;
#define PHASE_ENTER() KArgs kp_ = (KArgs)__builtin_amdgcn_kernarg_segment_ptr(); asm volatile("" : "+s"(kp_)); const Args a = *kp_; int tid = threadIdx.x; asm volatile("" : "+v"(tid)); \
    const int lane = tid & 63, wave = __builtin_amdgcn_readfirstlane(tid >> 6); const int G = gridDim.x, bx = blockIdx.x; (void)lane; (void)wave; (void)G; (void)bx; \
    float* modv = (float*)(a.ws + WS_MOD); bf16* H = (bf16*)(a.ws + WS_H); bf16* Z = (bf16*)(a.ws + WS_Z); (void)modv; (void)H; (void)Z;
__global__ void __launch_bounds__(NTHR, 2) mk_fwd(Args a0) {
#if defined(__HIP_DEVICE_COMPILE__)
    extern __shared__ __attribute__((aligned(16))) unsigned char lds_raw[];
    LAS unsigned char* lds = (LAS unsigned char*)lds_raw;
    if (threadIdx.x < 64) ((LAS unsigned*)(lds + MISC_OFF))[threadIdx.x] = 0u;
    __syncthreads();
    const int lo = a0.ph_lo, hi = a0.ph_hi;
    XcdBarrier bar; bar.bar = (unsigned*)(a0.ws + WS_CTL); bar.x = 0; bar.st = (volatile LAS unsigned*)(lds + MISC_OFF + 32);
    if (threadIdx.x == 0) { const unsigned x = xb_xcc_id() & 7u; volatile LAS unsigned* mz = (volatile LAS unsigned*)(lds + MISC_OFF);
        mz[4] = x; mz[5] = __hip_atomic_fetch_add((unsigned*)(a0.ws + WS_CTL) + CW_RANK + lo * 256 + x * 16, 1u, __ATOMIC_RELAXED, __HIP_MEMORY_SCOPE_AGENT); }
    __syncthreads();
    if (hi - lo > 1) bar = xcd_barrier_post((unsigned*)(a0.ws + WS_CTL), (volatile LAS unsigned*)(lds + MISC_OFF + 32));
#define IN(k) (lo <= (k) && (k) < hi)
#define SEAM(k) do { if (IN(k) && IN((k) + 1)) xcd_barrier(bar); } while (0)

    if (HAS(11) && IN(0)) { PHASE_ENTER(); REPEAT(11) p0_prologue(a, lds, tid, lane, wave); }
    SEAM(0);
    if (HAS(12) && IN(1)) { PHASE_ENTER(); REPEAT(12) {
#if !WCOL
        w_to_fp8(a, lds, lane, wave);
#endif
        norm_rows8<false>(a.in[0], a.in[4], modv, D, 0, lane, wave, a.ws + WS_H8, (float*)(a.ws + WS_HS)); } }
    SEAM(1);
#define PEER_MAP() PeerMap pm; { const volatile LAS unsigned* mz = (const volatile LAS unsigned*)(lds + MISC_OFF); pm.x = (int)mz[4]; pm.r = (int)mz[5]; int ok = (hi - lo > 1) && (G == 256) && (pm.r < 32); \
            const unsigned* rk = (const unsigned*)(a.ws + WS_CTL) + CW_RANK + lo * 256; for (int xx = 0; xx < 8; ++xx) ok = ok && (__hip_atomic_load(rk + xx * 16, __ATOMIC_RELAXED, __HIP_MEMORY_SCOPE_AGENT) == 32u); pm.fast = ok; }
#ifdef UNROLL_L
#pragma unroll
#else
#pragma unroll 1
#endif
    for (int l = 0; l < DEPTH; ++l) {
        const int pb = 2 + PPL * l;
        if (HAS(0) && IN(pb + 0)) { PHASE_ENTER(); REPEAT(0) {
            pg8::Gemm g{(const bf16*)(a.ws + WS_H8), (const bf16*)(a.ws + WS_WIN + (size_t)l * INC * D), M, INC, D}; pg8::StaticOrder S; S.init(M, INC, G, bx);
            pg8::EpiZ E{Z, INC, 16, (const float*)(a.ws + WS_HS), WCOL ? 1.0f : wscale(a, l, 0), (size_t)(32 * MiB / 2), (bf16*)(a.ws + WS_ZG), 1, WCOL ? (const float*)(a.ws + WS_WSC) + l * WSC_L + WSC_IN : nullptr, UGM ? M : 0};
            pg8::gemm_phase<pg8::EpiZ, pg8::StaticOrder, true, true, 2>(lds, g, S, E, tid);
        } }
        SEAM(pb + 0);
        if (HAS(1) && IN(pb + 1)) { PHASE_ENTER(); PEER_MAP(); REPEAT(1) { ssm_fused(a, lds, l, tid, lane, wave);
#ifdef SSM_TWICE
            ssm_fused(a, lds, l, tid, lane, wave);
#endif
            { PeerMap pg = pm; pg.fast = 0; attn_phase(a, lds, pg, tid, lane, wave);
#ifdef ATTN_TWICE
            attn_phase(a, lds, pg, tid, lane, wave);
#endif
            } } }
        SEAM(pb + 1);
        if (HAS(4) && IN(pb + 2)) { PHASE_ENTER(); REPEAT(4) {
            attn_combine(a, tid);
            pg8::Gemm g{(const bf16*)(a.ws + WS_Y), (const bf16*)(a.ws + WS_WGLU) + (size_t)l * 1024 * 1024, M, 1024, 1024}; pg8::StaticOrder S; S.init(M, 1024, G, bx);
            pg8::EpiMul<0> E{nullptr, 1024, (const bf16*)(a.ws + WS_Y), YGM ? M : 1024, 0, 1.0f, a.ws + WS_YS, 1.0f, nullptr};
            pg8::gemm_phase<pg8::EpiMul<0>, pg8::StaticOrder, false, true, 0, YGM != 0>(lds, g, S, E, tid);
        } }
        SEAM(pb + 2);
        if (HAS(5) && IN(pb + 3)) { PHASE_ENTER(); REPEAT(5) {
            { pg8::Gemm g{(const bf16*)(a.ws + WS_YS), (const bf16*)(a.ws + WS_WBRS + (size_t)l * D * 1024), M, D, 1024}; pg8::StaticOrder S; S.init(M, D, G, bx);
              pg8::EpiMul<1> E{(bf16*)(a.ws + WS_MG), D, (const bf16*)(a.ws + WS_ZG), 4096, 0, GATE_U8 ? 1.0f / 255.0f : 1.0f, nullptr, 1.0f, (const float*)(a.ws + WS_WSC) + l * WSC_L + WSC_BRS};
              pg8::gemm_phase<pg8::EpiMul<1>, pg8::StaticOrder, true, true, true>(lds, g, S, E, tid); }
            { pg8::Gemm g{(const bf16*)(a.ws + WS_YA), (const bf16*)(a.ws + WS_WBRA + (size_t)l * D * 1024), M, D, 1024}; pg8::StaticOrder S; S.init(M, D, G, bx);
              pg8::EpiMul<2> E{(bf16*)(a.ws + WS_MG), D, (const bf16*)(a.ws + WS_ZG), 4096, 2048, (GATE_U8 ? 1.0f / 255.0f : 1.0f) / YA_Q, a.ws + WS_MG8, MG_Q, (const float*)(a.ws + WS_WSC) + l * WSC_L + WSC_BRA};
              pg8::gemm_phase<pg8::EpiMul<2>, pg8::StaticOrder, true, true, true>(lds, g, S, E, tid); }
        } }
        SEAM(pb + 3);
        if (HAS(6) && IN(pb + 4)) { PHASE_ENTER();
            pg8::Gemm g{(const bf16*)(a.ws + WS_MG8), (const bf16*)(a.ws + WS_WOUT + (size_t)l * D * D), M, D, D}; pg8::StaticOrder S; S.init(M, D, G, bx);
            bf16* XB = (bf16*)(a.ws + WS_XB); const float* gm_ = modv + (size_t)l * NB * NMOD + 2 * D; const float cs_ = 1.0f / MG_Q; const float* csv_ = (const float*)(a.ws + WS_WSC) + l * WSC_L + WSC_OUT;
            if (l == 0) { pg8::EpiRes<false> E{(const void*)a.in[0], XB, D, gm_, NMOD, SEQ, cs_, csv_}; pg8::gemm_phase<pg8::EpiRes<false>, pg8::StaticOrder, true, true, true>(lds, g, S, E, tid); }
            else { pg8::EpiRes<true> E{(const void*)XB, XB, D, gm_, NMOD, SEQ, cs_, csv_}; pg8::gemm_phase<pg8::EpiRes<true>, pg8::StaticOrder, true, true, true>(lds, g, S, E, tid); }
        }
        SEAM(pb + 4);
        if (HAS(7) && IN(pb + 5)) { PHASE_ENTER(); REPEAT(7) {
#if WQ_I8
            norm_rows8<true>(a.ws + WS_XB, a.in[5] + (size_t)l * D, modv + (size_t)l * NB * NMOD, 4 * D, 3 * D, lane, wave, a.ws + WS_HQ, (float*)(a.ws + WS_HQS));
#else
            norm_phase<2, true>(a.ws + WS_XB, a.in[5] + (size_t)l * D, modv + (size_t)l * NB * NMOD, 4 * D, 3 * D, H, lane, wave, a.ws + WS_HQ, (float*)(a.ws + WS_HQS));
#endif
        } }
        SEAM(pb + 5);
        if (HAS(8) && IN(pb + 6)) { PHASE_ENTER(); REPEAT(8) {
#if WQ_I8
            pg8::Gemm g{(const bf16*)(a.ws + WS_HQ), (const bf16*)(a.ws + WS_WQ + (size_t)l * D * D), M, D, D}; pg8::StaticOrder S; S.init(M, D, G, bx);
            pg8::EpiZ E{(bf16*)(a.ws + WS_QP), D, 1 << 30, (const float*)(a.ws + WS_HQS), 1.0f, 0, nullptr, 1, (const float*)(a.ws + WS_WSC) + l * WSC_L + WSC_WQ, 0};
            pg8::gemm_phase<pg8::EpiZ, pg8::StaticOrder, true, true, 2>(lds, g, S, E, tid);
#else
            pg8::Gemm g{H, (const bf16*)(a.ws + WS_WQ) + (size_t)l * D * D, M, D, D}; pg8::StaticOrder S; S.init(M, D, G, bx);
            pg8::EpiZ E{(bf16*)(a.ws + WS_QP), D, 1 << 30, nullptr, 1.0f, 0, nullptr, 0, nullptr, 0};
            pg8::gemm_phase<pg8::EpiZ, pg8::StaticOrder, true, true>(lds, g, S, E, tid);
#endif
#if defined(PROBE_DUMMY) && PROBE_DUMMY == 1
            { pg8::EpiZ E2{(bf16*)(a.ws + WS_Z), D, 1 << 30, nullptr, 1.0f, 0, nullptr, 0, nullptr, 0}; pg8::gemm_phase<pg8::EpiZ, pg8::StaticOrder, true, true>(lds, g, S, E2, tid); }
#elif defined(PROBE_DUMMY) && PROBE_DUMMY == 2
            { pg8::EpiNull E2{(float*)(a.ws + WS_Z)}; pg8::gemm_phase<pg8::EpiNull, pg8::StaticOrder, true, true>(lds, g, S, E2, tid); }
#endif
        } }
        SEAM(pb + 6);
#if !PEER_FUSED
        if (HAS(9) && IN(pb + 7)) { PHASE_ENTER(); REPEAT(9) topk_phase(a, lds, l, tid, lane, wave, bx * NWAVES + wave, (M / 32) * 8, G * NWAVES, true); }
        SEAM(pb + 7);
#endif
#if PEER_FUSED
        if (HAS(10) && IN(pb + 7)) { PHASE_ENTER(); peer_fused_phase(a, lds, l, lane, wave); }
        SEAM(pb + 7);
#elif GATHER_V2
        if (HAS(10) && IN(pb + 8)) { PHASE_ENTER(); PEER_MAP(); REPEAT(13) peer_u_phase(a, l, pm, lane, wave); }
        SEAM(pb + 8);
        if (HAS(10) && IN(pb + 9)) { PHASE_ENTER(); REPEAT(14) peer_act_phase(a, l, lane, wave); }
        SEAM(pb + 9);
        if (HAS(10) && IN(pb + 10)) { PHASE_ENTER(); PEER_MAP(); peer_v_phase(a, l, pm, lane, wave); }
        SEAM(pb + 10);
        if (HAS(10) && IN(pb + 11)) { PHASE_ENTER(); peer_norm_phase(a, l, lane, wave); }
        SEAM(pb + 11);
#else
        if (HAS(10) && IN(pb + 8)) { PHASE_ENTER(); gather_phase(a, l, lane, wave); }
        SEAM(pb + 8);
#endif
    }
#ifdef EXTRA_BARRIERS
    if (hi - lo > 1) { for (int i_ = 0; i_ < EXTRA_BARRIERS; ++i_) xcd_barrier(bar); }
#endif
#undef IN
#undef SEAM
#endif
}

extern "C" void kernel_launch(void* const* d_in, const int* in_sizes, int n_in, void* d_out, int out_size, void* d_ws, size_t ws_size, hipStream_t stream) {
    static int grid = 0;
    if (grid == 0) {
        if (n_in != 24 || in_sizes[0] != M * D || out_size != M * D || ws_size < WS_END2) { fprintf(stderr, "kernel_launch: unexpected shapes (n_in %d, in0 %d, out %d, ws %zu < %zu)\n", n_in, n_in > 0 ? in_sizes[0] : -1, out_size, ws_size, (size_t)WS_END2); grid = -1; return; }
        int dev = 0, cus = 0, per_cu = 0;
        if (hipGetDevice(&dev) != hipSuccess || hipDeviceGetAttribute(&cus, hipDeviceAttributeMultiprocessorCount, dev) != hipSuccess) { grid = -1; return; }
        if (hipFuncSetAttribute((const void*)mk_fwd, hipFuncAttributeMaxDynamicSharedMemorySize, LDS_BYTES) != hipSuccess) { fprintf(stderr, "kernel_launch: hipFuncSetAttribute failed\n"); grid = -1; return; }
        if (hipOccupancyMaxActiveBlocksPerMultiprocessor(&per_cu, (const void*)mk_fwd, NTHR, LDS_BYTES) != hipSuccess || per_cu < 1) fprintf(stderr, "kernel_launch: occupancy query says %d\n", per_cu);
        (void)hipGetLastError();
        grid = cus;
    }
    if (grid < 0) return;
    (void)hipMemsetAsync((char*)d_ws + WS_CTL, 0, CTL_ZERO_BYTES, stream);
    Args a{};
    for (int i = 0; i < 24; ++i) a.in[i] = (const float*)d_in[i];
    a.out = (float*)d_out; a.ws = (unsigned char*)d_ws;
#if MK_PER_PHASE
#ifndef DUP_PHASE_MASK
#define DUP_PHASE_MASK 0u
#endif
    for (int ph = 0; ph < NPH; ++ph) { a.ph_lo = ph; a.ph_hi = ph + 1; for (int r = 0; r < 1 + (int)(((unsigned)(DUP_PHASE_MASK) >> ph) & 1u); ++r) hipLaunchKernelGGL(mk_fwd, dim3(grid), dim3(NTHR), LDS_BYTES, stream, a); }
#else
    a.ph_lo = 0; a.ph_hi = NPH; hipLaunchKernelGGL(mk_fwd, dim3(grid), dim3(NTHR), LDS_BYTES, stream, a);
#endif
}
```

```cpp
#include <hip/hip_runtime.h>
#include <cstdio>
#include <cstdint>
#include <type_traits>
#define MK_PER_PHASE 0
namespace pg8 {
#define PG8_LAS __attribute__((address_space(3)))
typedef unsigned short bf16_t;
typedef short bf16x8 __attribute__((ext_vector_type(8)));
typedef float f32x4 __attribute__((ext_vector_type(4)));
typedef unsigned u32x4 __attribute__((ext_vector_type(4)));
constexpr int BM = 256, BK = 64, HALF = 128, HTB = HALF * BK * 2  , STAGE_BYTES = 8 * HTB, NXCD = 8, WGM = 4;

__host__ __device__ __forceinline__ int lds_byte(int r, int c) { const int st = (r >> 4) * 2 + (c >> 5), rr = r & 15, cc = c & 31, ob = rr * 64 + cc * 2; return st * 1024 + (ob ^ (((ob >> 9) & 1) << 5)); }
__host__ __device__ __forceinline__ void stage_rc(int b, int& R, int& C) { const int st = b / 1024, sb = b % 1024, swz = sb ^ (((sb >> 9) & 1) << 5); R = (st >> 1) * 16 + swz / 64; C = (st & 1) * 32 + (swz % 64) / 2; }
__host__ __device__ __forceinline__ int perm32(int rho) { const int n = rho >> 4, i = rho & 15; return 8 * (i >> 2) + 4 * n + (i & 3); }

struct Unit { int pm, pn; };
struct Gemm { const bf16_t* A; const bf16_t* Bt; int M, N, K; };

struct StaticOrder {
    int nM, nN, nwg, G, c;
    __host__ __device__ void init(int M, int N, int G_, int c_) { nM = M / BM; nN = N / BM; nwg = nM * nN; G = G_; c = c_; }
    __host__ __device__ bool next(int i, Unit& u) const {
        const long L = (long)i * G + c; if (L >= nwg) return false;
        int wgid = (int)L; { const int q = nwg / NXCD, r = nwg % NXCD, xcd = wgid % NXCD, off = wgid / NXCD; wgid = (xcd < r ? xcd * (q + 1) : r * (q + 1) + (xcd - r) * q) + off; }
        const int nig = WGM * nN, gid = wgid / nig, fm = gid * WGM, gsz = (nM - fm) < WGM ? (nM - fm) : WGM;
        u.pm = fm + ((wgid % nig) % gsz); u.pn = (wgid % nig) / gsz; return true;
    }
    __device__ __forceinline__ void a_ready(const Unit&) const {}
    __device__ __forceinline__ void done(const Unit&) const {}
};

__device__ __forceinline__ unsigned cvt_pk_bf16(float lo, float hi) { unsigned r; asm volatile("v_cvt_pk_bf16_f32 %0, %1, %2" : "=v"(r) : "v"(lo), "v"(hi)); return r; }
typedef float f32x2 __attribute__((ext_vector_type(2)));
__device__ __forceinline__ f32x2 gelu_pk(f32x2 v) {
    const f32x2 av = __builtin_elementwise_abs(v), d = av * 0.2316418882f + 1.0f;
    f32x2 t; t.x = __builtin_amdgcn_rcpf(d.x); t.y = __builtin_amdgcn_rcpf(d.y);
    f32x2 q = t * 0.5307027145f + (-0.7265760135f); q = q * t + 0.7107068705f; q = q * t + (-0.142248368f); q = q * t + 0.127414796f; q = q * t;
    const f32x2 s = (v * v) * (-0.72134752044f);
    f32x2 e; e.x = __builtin_amdgcn_exp2f(s.x); e.y = __builtin_amdgcn_exp2f(s.y);
    const f32x2 m = v * (q * e), r = v - m;
    f32x2 o; o.x = v.x < 0.f ? m.x : r.x; o.y = v.y < 0.f ? m.y : r.y; return o;
}
#ifndef EPI_NT
#define EPI_NT 0
#endif
#if EPI_NT
#define EPI_ST(p, v) __builtin_nontemporal_store((v), (p))
#else
#define EPI_ST(p, v) (*(p) = (v))
#endif
#ifndef EPI_NT_LD
#define EPI_NT_LD 0
#endif
#if EPI_NT_LD
#define EPI_LD(p) __builtin_nontemporal_load(p)
#else
#define EPI_LD(p) (*(p))
#endif
#ifndef UGM
#define UGM 1
#endif
#ifndef EPI_BI_RES_BF
#define EPI_BI_RES_BF 4
#define EPI_BI_RES_F32 4
#endif
#ifndef EPI_BI
#define EPI_BI(MODE) ((MODE) == 2 ? 4 : (MODE) == 1 ? 16 : 8)
#endif
#ifndef YGM
#define YGM 1
#endif
#ifndef GATE_U8
#define GATE_U8 1
#endif
__device__ __forceinline__ float sigm(float x) { return __builtin_amdgcn_rcpf(1.0f + __builtin_amdgcn_exp2f(-1.4426950408889634f * x)); }
__device__ __forceinline__ float bf_lo(unsigned u) { return __uint_as_float(u << 16); }
__device__ __forceinline__ float bf_hi(unsigned u) { return __uint_as_float(u & 0xffff0000u); }
__device__ __forceinline__ void pk8_fp8(const float (&o)[8], float q, unsigned& w0, unsigned& w1) {
    float c[8];
#pragma unroll
    for (int j = 0; j < 8; ++j) c[j] = __builtin_fminf(__builtin_fmaxf(o[j] * q, -440.0f), 440.0f);
    int a = __builtin_amdgcn_cvt_pk_fp8_f32(c[0], c[1], 0, false); a = __builtin_amdgcn_cvt_pk_fp8_f32(c[2], c[3], a, true);
    int b = __builtin_amdgcn_cvt_pk_fp8_f32(c[4], c[5], 0, false); b = __builtin_amdgcn_cvt_pk_fp8_f32(c[6], c[7], b, true); w0 = (unsigned)a; w1 = (unsigned)b;
}
struct EpiZ {
    static constexpr bool PERM = true, AFTER_DRAIN = false;
    bf16_t* O; int ldc; int sig_from; const float* rs; float cs; size_t split4; bf16_t* G; int iacc; const float* csv; int ugm;
    __device__ __forceinline__ void operator()(const f32x4 (&acc)[2][2][4][2], const Unit& u, int wr, int wc, int fr, int fq) const {
        const int row0 = u.pm * BM + wr * 64 + fr; const bool sg = u.pn >= sig_from;
        f32x4 cv[2][2];
#pragma unroll
        for (int bj = 0; bj < 2; ++bj)
#pragma unroll
            for (int n = 0; n < 2; ++n) cv[bj][n] = csv ? *(const f32x4*)(csv + u.pn * BM + wc * 32 + 8 * fq + bj * HALF + 4 * n) : (f32x4){1.f, 1.f, 1.f, 1.f};
        bf16_t* base = O; int ld = ldc, colt = u.pn * BM;
        if (split4) { if (u.pn < 16) { base = O + (size_t)(u.pn >> 2) * split4; ld = 1024; colt = (u.pn & 3) * BM; } else { base = G; ld = 4096; colt = (u.pn - 16) * BM; } }
        const int col0 = colt + wc * 32 + 8 * fq;
#pragma unroll
        for (int ai = 0; ai < 2; ++ai)
#pragma unroll
            for (int m = 0; m < 4; ++m) { const int r = row0 + ai * HALF + m * 16; bf16_t* rowp = base + (size_t)r * ld + col0; const float sc = rs ? rs[r] * cs : 1.0f;
#pragma unroll
                for (int bj = 0; bj < 2; ++bj) { f32x4 v0 = acc[ai][bj][m][0], v1 = acc[ai][bj][m][1];
                    if (iacc) {
#pragma unroll
                        for (int j = 0; j < 4; ++j) { v0[j] = (float)__float_as_int(v0[j]); v1[j] = (float)__float_as_int(v1[j]); } }
#if GATE_U8
                    if (split4 && sg) {
                        const float scn = sc * -1.4426950408889634f; v0 *= scn; v1 *= scn; if (csv) { v0 *= cv[bj][0]; v1 *= cv[bj][1]; }
                        unsigned w0 = 0u, w1 = 0u;
#pragma unroll
                        for (int j = 0; j < 4; ++j) { const float g0 = __builtin_amdgcn_rcpf(__builtin_fmaf(__builtin_amdgcn_exp2f(v0[j]), 1.0f / 255.0f, 1.0f / 255.0f)), g1 = __builtin_amdgcn_rcpf(__builtin_fmaf(__builtin_amdgcn_exp2f(v1[j]), 1.0f / 255.0f, 1.0f / 255.0f));
                            w0 = __builtin_amdgcn_cvt_pk_u8_f32(g0, j, w0); w1 = __builtin_amdgcn_cvt_pk_u8_f32(g1, j, w1); }
                        typedef unsigned u32x2_ __attribute__((ext_vector_type(2)));
                        EPI_ST((u32x2_*)((unsigned char*)G + (size_t)r * 4096 + col0 + bj * HALF), ((u32x2_){w0, w1})); continue; }
#endif
                    v0 *= sc; v1 *= sc; if (csv) { v0 *= cv[bj][0]; v1 *= cv[bj][1]; }
                    if (sg) {
#pragma unroll
                        for (int j = 0; j < 4; ++j) { v0[j] = sigm(v0[j]); v1[j] = sigm(v1[j]); } }
                    u32x4 w; w.x = cvt_pk_bf16(v0[0], v0[1]); w.y = cvt_pk_bf16(v0[2], v0[3]); w.z = cvt_pk_bf16(v1[0], v1[1]); w.w = cvt_pk_bf16(v1[2], v1[3]);
                    if (ugm && split4 && u.pn < 4) { const int c_ = col0 + bj * HALF; EPI_ST((u32x4*)(O + ((size_t)(c_ >> 4) * ugm + r) * 16 + (c_ & 15)), w); }
                    else EPI_ST((u32x4*)(rowp + bj * HALF), w); } }
    }
};
template <int MODE> struct EpiMul {
    static constexpr bool PERM = true, AFTER_DRAIN = false;
    bf16_t* O; int ldc; const bf16_t* Y; int ldy; int gcol; float cs; unsigned char* O8; float oq; const float* csv;
    typedef unsigned u32x2_ __attribute__((ext_vector_type(2)));
    struct Ld { u32x4 yv; u32x2_ yb; u32x4 pv; };
    __device__ __forceinline__ void load(Ld& x, int it, int row0, int col0) const {
        const int ai = it >> 3, m = (it >> 1) & 3, bj = it & 1; const size_t r = (size_t)(row0 + ai * HALF + m * 16);
#if GATE_U8
        if (MODE != 0) x.yb = EPI_LD((const u32x2_*)((const unsigned char*)Y + r * ldy + gcol + col0 + bj * HALF));
        else
#endif
        { const int cy_ = gcol + col0 + bj * HALF;
          x.yv = (YGM && MODE == 0) ? EPI_LD((const u32x4*)(Y + ((size_t)(cy_ >> 4) * ldy + r) * 16 + (cy_ & 15))) : EPI_LD((const u32x4*)(Y + r * ldy + cy_)); }
        if (MODE == 2) x.pv = EPI_LD((const u32x4*)(O + r * ldc + col0 + bj * HALF));
    }
    __device__ __forceinline__ void work(const Ld& x, int it, const f32x4 (&acc)[2][2][4][2], const f32x4 (&cv)[2][2], int row0, int col0) const {
        const int ai = it >> 3, m = (it >> 1) & 3, bj = it & 1; const size_t r = (size_t)(row0 + ai * HALF + m * 16);
        const f32x4 v0 = acc[ai][bj][m][0], v1 = acc[ai][bj][m][1];
        float y[8];
#if GATE_U8
        if (MODE != 0) { y[0] = (float)(x.yb.x & 255u); y[1] = (float)((x.yb.x >> 8) & 255u); y[2] = (float)((x.yb.x >> 16) & 255u); y[3] = (float)(x.yb.x >> 24);
            y[4] = (float)(x.yb.y & 255u); y[5] = (float)((x.yb.y >> 8) & 255u); y[6] = (float)((x.yb.y >> 16) & 255u); y[7] = (float)(x.yb.y >> 24); }
        else
#endif
        { y[0] = bf_lo(x.yv.x); y[1] = bf_hi(x.yv.x); y[2] = bf_lo(x.yv.y); y[3] = bf_hi(x.yv.y); y[4] = bf_lo(x.yv.z); y[5] = bf_hi(x.yv.z); y[6] = bf_lo(x.yv.w); y[7] = bf_hi(x.yv.w); }
        float o[8];
        if (MODE == 0) {
#pragma unroll
            for (int j = 0; j < 4; ++j) { o[j] = y[j] * sigm(v0[j]); o[4 + j] = y[4 + j] * sigm(v1[j]); } }
        else {
#pragma unroll
            for (int j = 0; j < 4; ++j) { o[j] = y[j] * (v0[j] * cv[bj][0][j]); o[4 + j] = y[4 + j] * (v1[j] * cv[bj][1][j]); }
            if (MODE == 2) { o[0] += bf_lo(x.pv.x); o[1] += bf_hi(x.pv.x); o[2] += bf_lo(x.pv.y); o[3] += bf_hi(x.pv.y); o[4] += bf_lo(x.pv.z); o[5] += bf_hi(x.pv.z); o[6] += bf_lo(x.pv.w); o[7] += bf_hi(x.pv.w); } }
        if (MODE == 1) { u32x4 w; w.x = cvt_pk_bf16(o[0], o[1]); w.y = cvt_pk_bf16(o[2], o[3]); w.z = cvt_pk_bf16(o[4], o[5]); w.w = cvt_pk_bf16(o[6], o[7]);
            EPI_ST((u32x4*)(O + r * ldc + col0 + bj * HALF), w); }
        else { unsigned w0, w1; pk8_fp8(o, oq, w0, w1); EPI_ST((u32x2_*)(O8 + r * ldc + col0 + bj * HALF), ((u32x2_){w0, w1})); }
    }
    __device__ __forceinline__ void operator()(const f32x4 (&acc)[2][2][4][2], const Unit& u, int wr, int wc, int fr, int fq) const {
        const int row0 = u.pm * BM + wr * 64 + fr, col0 = u.pn * BM + wc * 32 + 8 * fq;
        f32x4 cv[2][2];
        if (MODE != 0) {
#pragma unroll
            for (int bj = 0; bj < 2; ++bj)
#pragma unroll
                for (int n = 0; n < 2; ++n) cv[bj][n] = *(const f32x4*)(csv + col0 + bj * HALF + 4 * n) * cs; }
        constexpr int BI = EPI_BI(MODE), NBLK = 16 / BI;
        Ld ld[2][BI];
#pragma unroll
        for (int i = 0; i < BI; ++i) load(ld[0][i], i, row0, col0);
#pragma unroll
        for (int b = 0; b < NBLK; ++b) {
            if (b + 1 < NBLK) {
#pragma unroll
                for (int i = 0; i < BI; ++i) load(ld[(b + 1) & 1][i], (b + 1) * BI + i, row0, col0); }
            asm volatile("" ::: "memory");
#pragma unroll
            for (int i = 0; i < BI; ++i) work(ld[b & 1][i], b * BI + i, acc, cv, row0, col0);
            asm volatile("" ::: "memory"); }
    }
};
template <bool BF> struct EpiRes {
    static constexpr bool PERM = true, AFTER_DRAIN = false;
    const void* base; bf16_t* out; int ldc; const float* gate; int gate_bstride; int rows_per_batch; float cs; const float* csv;
    struct Ld { u32x4 pv; f32x4 b0, b1; };
    __device__ __forceinline__ void load(Ld& x, int it, int row0, int col0) const {
        const int ai = it >> 3, m = (it >> 1) & 3, bj = it & 1; const size_t off = (size_t)(row0 + ai * HALF + m * 16) * ldc + col0;
        if (BF) x.pv = EPI_LD((const u32x4*)((const bf16_t*)base + off + bj * HALF));
        else { x.b0 = EPI_LD((const f32x4*)((const float*)base + off + bj * HALF)); x.b1 = EPI_LD((const f32x4*)((const float*)base + off + bj * HALF + 4)); }
    }
    __device__ __forceinline__ void work(const Ld& x, int it, const f32x4 (&acc)[2][2][4][2], const f32x4 (&gv)[2][2], int row0, int col0) const {
        const int ai = it >> 3, m = (it >> 1) & 3, bj = it & 1; const size_t off = (size_t)(row0 + ai * HALF + m * 16) * ldc + col0;
        f32x4 b0, b1;
        if (BF) { b0 = (f32x4){bf_lo(x.pv.x), bf_hi(x.pv.x), bf_lo(x.pv.y), bf_hi(x.pv.y)}; b1 = (f32x4){bf_lo(x.pv.z), bf_hi(x.pv.z), bf_lo(x.pv.w), bf_hi(x.pv.w)}; } else { b0 = x.b0; b1 = x.b1; }
        const f32x4 o0 = b0 + gv[bj][0] * acc[ai][bj][m][0], o1 = b1 + gv[bj][1] * acc[ai][bj][m][1];
        u32x4 w; w.x = cvt_pk_bf16(o0[0], o0[1]); w.y = cvt_pk_bf16(o0[2], o0[3]); w.z = cvt_pk_bf16(o1[0], o1[1]); w.w = cvt_pk_bf16(o1[2], o1[3]);
        EPI_ST((u32x4*)(out + off + bj * HALF), w);
    }
    __device__ __forceinline__ void operator()(const f32x4 (&acc)[2][2][4][2], const Unit& u, int wr, int wc, int fr, int fq) const {
        const int row0 = u.pm * BM + wr * 64 + fr, col0 = u.pn * BM + wc * 32 + 8 * fq;
        const float* gp = gate + (size_t)((u.pm * BM) / rows_per_batch) * gate_bstride + col0;
        f32x4 gv[2][2];
#pragma unroll
        for (int bj = 0; bj < 2; ++bj)
#pragma unroll
            for (int n = 0; n < 2; ++n) gv[bj][n] = *(const f32x4*)(gp + bj * HALF + 4 * n) * (*(const f32x4*)(csv + col0 + bj * HALF + 4 * n) * cs);
        constexpr int BI = BF ? EPI_BI_RES_BF : EPI_BI_RES_F32, NBLK = 16 / BI;
        Ld ld[2][BI];
#pragma unroll
        for (int i = 0; i < BI; ++i) load(ld[0][i], i, row0, col0);
#pragma unroll
        for (int b = 0; b < NBLK; ++b) {
            if (b + 1 < NBLK) {
#pragma unroll
                for (int i = 0; i < BI; ++i) load(ld[(b + 1) & 1][i], (b + 1) * BI + i, row0, col0); }
            asm volatile("" ::: "memory");
#pragma unroll
            for (int i = 0; i < BI; ++i) work(ld[b & 1][i], b * BI + i, acc, gv, row0, col0);
            asm volatile("" ::: "memory"); }
    }
};

struct EpiNull {
    static constexpr bool PERM = true, AFTER_DRAIN = false;
    float* O;
    __device__ __forceinline__ void operator()(const f32x4 (&acc)[2][2][4][2], const Unit& u, int wr, int wc, int fr, int fq) const {
        float s = 0.f;
#pragma unroll
        for (int ai = 0; ai < 2; ++ai)
#pragma unroll
            for (int bj = 0; bj < 2; ++bj)
#pragma unroll
                for (int m = 0; m < 4; ++m)
#pragma unroll
                    for (int n = 0; n < 2; ++n) s += acc[ai][bj][m][n][0];
        O[(size_t)(u.pm * 8 + u.pn) * 512 + (wr * 4 + wc) * 64 + fr + 16 * fq] = s;
    }
};
template <class Epi, class Sched, bool ALIGN_EPI = false, bool SP2 = false, int QM = 0, bool AGM = false>
__device__ __forceinline__ void gemm_phase(PG8_LAS unsigned char* lds, const Gemm g, const Sched& S, const Epi& E, const int tid) {
    const int wid = __builtin_amdgcn_readfirstlane(tid >> 6), lane = tid & 63, wr = wid >> 2, wc = wid & 3, fr = lane & 15, fq = lane >> 4;
    constexpr bool F8 = (QM == 1); constexpr int ESZ = QM ? 1 : 2;
    const int K = g.K, nt = K * ESZ / (BK * 2);
    unsigned voffA[2], voffB[2];
#pragma unroll
    for (int i = 0; i < 2; ++i) { int R, C; stage_rc(tid * 16 + i * 8192, R, C); const int Rb = Epi::PERM ? ((R & ~31) + perm32(R & 31)) : R;
        voffA[i] = AGM ? (unsigned)((C >> 4) * (g.M * 32) + R * 32 + (C & 8) * 2) : (unsigned)(R * K * ESZ + C * 2); voffB[i] = (unsigned)(Rb * K * ESZ + C * 2); }
    const size_t kstep = (size_t)(BK * 2);
    const size_t hstep = (size_t)HALF * K * ESZ;
    const size_t tstep = 2 * hstep;
    const size_t kstepA = AGM ? (size_t)(BK / 16) * g.M * 32 : kstep, hstepA = AGM ? (size_t)HALF * 32 : hstep, tstepA = 2 * hstepA;
    const unsigned ldsw = (unsigned)wid * 1024u;
    const int aoff = lds_byte(wr * 64 + fr, fq * 8), boff = lds_byte(wc * 32 + fr, fq * 8);
#define PG8_SA(b, h) (((b) * 2 + (h)) * HTB)
#define PG8_SB(b, h) ((4 + (b) * 2 + (h)) * HTB)
#define PG8_STAGE(bufoff, gbase, voff) do { _Pragma("unroll") for (int _i = 0; _i < 2; ++_i) \
        __builtin_amdgcn_global_load_lds((const unsigned*)((const char*)(gbase) + (voff)[_i]), (PG8_LAS unsigned*)(lds + (bufoff) + ldsw + _i * 8192), 16, 0, 0); } while (0)
#define PG8_LDA(dst, b, h) do { _Pragma("unroll") for (int m = 0; m < 4; ++m) { if constexpr (F8) { const v4i_ lo_ = *(const PG8_LAS v4i_*)(lds + PG8_SA(b, h) + aoff + m * 2048), hi_ = *(const PG8_LAS v4i_*)(lds + PG8_SA(b, h) + aoff + m * 2048 + 1024); \
            dst[m][0] = __builtin_bit_cast(frag_t, __builtin_shufflevector(lo_, hi_, 0, 1, 2, 3, 4, 5, 6, 7)); } \
        else { _Pragma("unroll") for (int k = 0; k < 2; ++k) dst[m][k] = __builtin_bit_cast(frag_t, *(const PG8_LAS bf16x8*)(lds + PG8_SA(b, h) + aoff + m * 2048 + k * 1024)); } } } while (0)
#define PG8_LDB(dst, b, h) do { _Pragma("unroll") for (int n = 0; n < 2; ++n) { if constexpr (F8) { const v4i_ lo_ = *(const PG8_LAS v4i_*)(lds + PG8_SB(b, h) + boff + n * 2048), hi_ = *(const PG8_LAS v4i_*)(lds + PG8_SB(b, h) + boff + n * 2048 + 1024); \
            dst[n][0] = __builtin_bit_cast(frag_t, __builtin_shufflevector(lo_, hi_, 0, 1, 2, 3, 4, 5, 6, 7)); } \
        else { _Pragma("unroll") for (int k = 0; k < 2; ++k) dst[n][k] = __builtin_bit_cast(frag_t, *(const PG8_LAS bf16x8*)(lds + PG8_SB(b, h) + boff + n * 2048 + k * 1024)); } } } while (0)
#define PG8_MMA(ai, bj, At, Bt) do { __builtin_amdgcn_s_setprio(1); \
        if constexpr (QM == 2) {   \
            _Pragma("unroll") for (int k = 0; k < 2; ++k) _Pragma("unroll") for (int m = 0; m < 4; ++m) _Pragma("unroll") for (int n = 0; n < 2; ++n) \
                asm volatile("v_mfma_i32_16x16x64_i8 %0, %1, %2, %0" : "+v"(acc[ai][bj][m][n]) : "v"(__builtin_bit_cast(bf16x8, Bt[n][k])), "v"(__builtin_bit_cast(bf16x8, At[m][k]))); } \
        else { _Pragma("unroll") for (int m = 0; m < 4; ++m) _Pragma("unroll") for (int n = 0; n < 2; ++n) { \
            if constexpr (F8) { asm volatile("v_mfma_f32_16x16x128_f8f6f4 %0, %1, %2, %0" : "+v"(acc[ai][bj][m][n]) : "v"(__builtin_bit_cast(v8i_, Bt[n][0])), "v"(__builtin_bit_cast(v8i_, At[m][0]))); }     \
            else { _Pragma("unroll") for (int k = 0; k < (F8 ? 1 : 2); ++k) acc[ai][bj][m][n] = __builtin_amdgcn_mfma_f32_16x16x32_bf16(__builtin_bit_cast(bf16x8, Bt[n][k]), __builtin_bit_cast(bf16x8, At[m][k]), acc[ai][bj][m][n], 0, 0, 0); } } } \
        __builtin_amdgcn_s_setprio(0); } while (0)
#define PG8_WAIT_V(n) asm volatile("s_waitcnt vmcnt(" #n ")" ::: "memory")
#define PG8_WAIT_L(n) asm volatile("s_waitcnt lgkmcnt(" #n ")" ::: "memory")
#define PG8_BAR __builtin_amdgcn_s_barrier()
#define PG8_SCHED __builtin_amdgcn_sched_barrier(0)
    Unit cur, nxt; int ui = 0;
    if (!S.next(0, cur)) return;
    f32x4 acc[2][2][4][2];
#pragma unroll
    for (int a = 0; a < 2; ++a)
#pragma unroll
        for (int b = 0; b < 2; ++b)
#pragma unroll
            for (int m = 0; m < 4; ++m)
#pragma unroll
                for (int n = 0; n < 2; ++n) acc[a][b][m][n] = (f32x4){0.f, 0.f, 0.f, 0.f};
    typedef int v4i_ __attribute__((ext_vector_type(4))); typedef int v8i_ __attribute__((ext_vector_type(8)));
    typedef typename std::conditional<F8, v8i_, bf16x8>::type frag_t;
    frag_t At[4][F8 ? 1 : 2], B0[2][F8 ? 1 : 2], B1[2][F8 ? 1 : 2];
    const char* cA = (const char*)g.A + (size_t)cur.pm * tstepA; const char* cB = (const char*)g.Bt + (size_t)cur.pn * tstep;
    S.a_ready(cur);
    if constexpr (SP2) {
        PG8_STAGE(PG8_SB(0, 0), cB, voffB); PG8_STAGE(PG8_SB(0, 1), cB + hstep, voffB); PG8_STAGE(PG8_SA(0, 0), cA, voffA); PG8_STAGE(PG8_SA(0, 1), cA + hstepA, voffA);
        if (wr == 1) PG8_BAR;
        PG8_WAIT_V(2); PG8_BAR;
        PG8_STAGE(PG8_SB(1, 0), cB + kstep, voffB); PG8_STAGE(PG8_SA(1, 0), cA + kstepA, voffA); PG8_STAGE(PG8_SB(1, 1), cB + hstep + kstep, voffB);
        PG8_WAIT_V(6); PG8_BAR;
    } else {
        PG8_STAGE(PG8_SB(0, 0), cB, voffB); PG8_STAGE(PG8_SA(0, 0), cA, voffA); PG8_STAGE(PG8_SB(0, 1), cB + hstep, voffB); PG8_STAGE(PG8_SA(0, 1), cA + hstepA, voffA);
        if (wr == 1) PG8_BAR;
        PG8_WAIT_V(4); PG8_BAR;
        PG8_STAGE(PG8_SB(1, 0), cB + kstep, voffB); PG8_STAGE(PG8_SA(1, 0), cA + kstepA, voffA); PG8_STAGE(PG8_SB(1, 1), cB + hstep + kstep, voffB);
        PG8_WAIT_V(6); PG8_BAR;
    }
    for (;;) {
        const bool has_next = S.next(ui + 1, nxt);
        const char* nA = has_next ? (const char*)g.A + (size_t)nxt.pm * tstepA : cA; const char* nB = has_next ? (const char*)g.Bt + (size_t)nxt.pn * tstep : cB;
        for (int t = 0; t < nt; t += 2) {
            const bool last = (t == nt - 2);
            const char* a1 = cA + (size_t)(t + 1) * kstepA;
            const char* a2 = last ? nA : cA + (size_t)(t + 2) * kstepA; const char* b2 = last ? nB : cB + (size_t)(t + 2) * kstep;
            const char* a3 = a2 + kstepA; const char* b3 = b2 + kstep;
            if (last && has_next) S.a_ready(nxt);
            if constexpr (SP2) {
            PG8_LDB(B0, 0, 0); PG8_LDB(B1, 0, 1); PG8_SCHED; PG8_LDA(At, 0, 0); PG8_STAGE(PG8_SA(1, 1), a1 + hstepA, voffA);
            PG8_WAIT_V(8); PG8_WAIT_L(0); PG8_BAR; PG8_MMA(0, 0, At, B0); PG8_MMA(0, 1, At, B1); PG8_BAR; PG8_SCHED;
            PG8_LDA(At, 0, 1); PG8_STAGE(PG8_SB(0, 0), b2, voffB); PG8_STAGE(PG8_SB(0, 1), b2 + hstep, voffB); PG8_STAGE(PG8_SA(0, 0), a2, voffA);
            PG8_WAIT_V(8); PG8_WAIT_L(0); PG8_BAR; PG8_MMA(1, 0, At, B0); PG8_MMA(1, 1, At, B1); PG8_BAR; PG8_SCHED;
            PG8_LDB(B0, 1, 0); PG8_LDB(B1, 1, 1); PG8_SCHED; PG8_LDA(At, 1, 0); PG8_STAGE(PG8_SA(0, 1), a2 + hstepA, voffA);
            PG8_WAIT_V(8); PG8_WAIT_L(0); PG8_BAR; PG8_MMA(0, 0, At, B0); PG8_MMA(0, 1, At, B1); PG8_BAR; PG8_SCHED;
            PG8_LDA(At, 1, 1); PG8_STAGE(PG8_SB(1, 0), b3, voffB); PG8_STAGE(PG8_SB(1, 1), b3 + hstep, voffB); PG8_STAGE(PG8_SA(1, 0), a3, voffA);
            PG8_WAIT_V(8); PG8_WAIT_L(0); PG8_BAR; PG8_MMA(1, 0, At, B0); PG8_MMA(1, 1, At, B1); PG8_BAR; PG8_SCHED;
            } else {
            PG8_LDB(B0, 0, 0); PG8_SCHED; PG8_LDA(At, 0, 0); PG8_STAGE(PG8_SA(1, 1), a1 + hstepA, voffA);
            PG8_WAIT_L(8); PG8_BAR; PG8_WAIT_L(0); PG8_MMA(0, 0, At, B0); PG8_BAR; PG8_SCHED;
            PG8_LDB(B1, 0, 1); PG8_STAGE(PG8_SB(0, 0), b2, voffB);
            PG8_BAR; PG8_WAIT_L(0); PG8_MMA(0, 1, At, B1); PG8_BAR;
            PG8_LDA(At, 0, 1); PG8_STAGE(PG8_SA(0, 0), a2, voffA);
            PG8_BAR; PG8_WAIT_L(0); PG8_MMA(1, 0, At, B0); PG8_BAR; PG8_SCHED;
            PG8_STAGE(PG8_SB(0, 1), b2 + hstep, voffB);
            PG8_WAIT_V(6); PG8_BAR; PG8_MMA(1, 1, At, B1); PG8_BAR;
            PG8_LDB(B0, 1, 0); PG8_SCHED; PG8_LDA(At, 1, 0); PG8_STAGE(PG8_SA(0, 1), a2 + hstepA, voffA);
            PG8_WAIT_L(8); PG8_BAR; PG8_WAIT_L(0); PG8_MMA(0, 0, At, B0); PG8_BAR; PG8_SCHED;
            PG8_LDB(B1, 1, 1); PG8_STAGE(PG8_SB(1, 0), b3, voffB);
            PG8_BAR; PG8_WAIT_L(0); PG8_MMA(0, 1, At, B1); PG8_BAR;
            PG8_LDA(At, 1, 1); PG8_STAGE(PG8_SA(1, 0), a3, voffA);
            PG8_BAR; PG8_WAIT_L(0); PG8_MMA(1, 0, At, B0); PG8_BAR; PG8_SCHED;
            PG8_STAGE(PG8_SB(1, 1), b3 + hstep, voffB);
            PG8_WAIT_V(6); PG8_BAR; PG8_MMA(1, 1, At, B1); PG8_BAR;
            }
        }
        if constexpr (ALIGN_EPI) { if (wr == 0) PG8_BAR; }
        if constexpr (!Epi::AFTER_DRAIN) { E(acc, cur, wr, wc, fr, fq); S.done(cur); }
        if (!has_next) break;
#pragma unroll
        for (int a = 0; a < 2; ++a)
#pragma unroll
            for (int b = 0; b < 2; ++b)
#pragma unroll
                for (int m = 0; m < 4; ++m)
#pragma unroll
                    for (int n = 0; n < 2; ++n) acc[a][b][m][n] = (f32x4){0.f, 0.f, 0.f, 0.f};
        cur = nxt; cA = nA; cB = nB; ++ui;
        if constexpr (ALIGN_EPI) { if (wr == 1) PG8_BAR; }
    }
    PG8_WAIT_V(0);
    if constexpr (!ALIGN_EPI) { if (wr == 0) PG8_BAR; }
    PG8_BAR;
    if constexpr (Epi::AFTER_DRAIN) { E.fused(acc, cur, wr, wc, fr, fq, lds, wid, lane); S.done(cur); }
#undef PG8_SA
#undef PG8_SB
#undef PG8_STAGE
#undef PG8_LDA
#undef PG8_LDB
#undef PG8_MMA
#undef PG8_WAIT_V
#undef PG8_WAIT_L
#undef PG8_BAR
#undef PG8_SCHED
}
}
constexpr int D = 2048, NB = 4, SEQ = 4096, M = NB * SEQ, DEPTH = 2, INC = 8192, NMOD = 6 * D;
constexpr int NE = 16384;
constexpr float EPS = 1e-6f;
constexpr int NWAVES = 8, NTHR = 512;
constexpr size_t MiB = 1u << 20;
constexpr size_t WS_CTL = 0, CTL_ZERO_BYTES = 64 * 1024;
constexpr size_t WS_MOD = 1 * MiB;
constexpr size_t WS_A16 = WS_MOD + 393216;
constexpr size_t WS_SKB = WS_A16 + 65536;
constexpr size_t WS_DS = WS_SKB + 131072;
constexpr size_t WS_WSC = WS_DS + 262144;
constexpr int WSC_L = 16384, WSC_IN = 0, WSC_BRS = 8192, WSC_BRA = 10240, WSC_OUT = 12288, WSC_WQ = 14336;
static_assert(WS_WSC + 2 * WSC_L * 4 <= 2 * MiB, "scale table overlaps the SSM tables");
#ifndef WQ_I8
#define WQ_I8 1
#endif
constexpr size_t WS_TF = 2 * MiB;
constexpr size_t WS_WF = WS_TF + 2 * MiB;
constexpr size_t WS_BF = WS_WF + 8 * MiB;
constexpr size_t WS_WIN = WS_BF + 8 * MiB;
constexpr size_t WS_WGLU = WS_WIN + 64 * MiB;
constexpr size_t WS_WBRS = WS_WGLU + 4 * MiB;
constexpr size_t WS_WBRA = WS_WBRS + 8 * MiB;
constexpr size_t WS_WOUT = WS_WBRA + 8 * MiB;
constexpr size_t WS_WQ = WS_WOUT + 16 * MiB;
constexpr size_t WS_PU = WS_WQ + 16 * MiB;
constexpr size_t WS_PV = WS_PU + 64 * MiB;
constexpr size_t WS_H = WS_PV + 64 * MiB;
constexpr size_t WS_Z = WS_H + 64 * MiB;
constexpr size_t WS_ZU = WS_Z, WS_ZQ = WS_Z + 32 * MiB, WS_ZK = WS_Z + 64 * MiB, WS_ZV = WS_Z + 96 * MiB, WS_ZG = WS_Z + 128 * MiB;
constexpr size_t WS_Y = WS_Z + 256 * MiB;
constexpr size_t WS_YS = WS_Y + 32 * MiB;
constexpr size_t WS_YA = WS_YS + 32 * MiB;
constexpr size_t WS_OB = WS_YA + 32 * MiB;
constexpr size_t WS_QP = WS_OB;
constexpr size_t WS_LSE = WS_OB + 96 * MiB;
constexpr size_t WS_MG = WS_LSE + 2 * MiB;
constexpr size_t WS_HLOC = WS_MG, WS_HPREV = WS_MG + 32 * MiB;
constexpr size_t WS_IDS = WS_MG + 64 * MiB;
constexpr size_t WS_GATE = WS_IDS + 8 * MiB;
constexpr size_t WS_IDS16 = WS_GATE + 8 * MiB;
constexpr size_t WS_IDS16T = WS_IDS16 + 4 * MiB;
constexpr size_t WS_H8 = WS_IDS16T + 4 * MiB;
constexpr size_t WS_HS = WS_H8 + 32 * MiB;
constexpr size_t WS_END = WS_HS + 1 * MiB;
constexpr size_t WS_P = WS_Z;
constexpr size_t WS_W = WS_Z + 128 * MiB;
constexpr size_t WS_HQ = WS_HS + 1 * MiB;
constexpr size_t WS_HQS = WS_HQ + 32 * MiB;
constexpr size_t WS_WQ8 = WS_HQS + 1 * MiB;
constexpr size_t WS_WS = WS_WQ8 + 2 * MiB;
constexpr size_t WS_MG8 = WS_WS + 1 * MiB;
constexpr size_t WS_XB = WS_MG8 + 32 * MiB;
constexpr size_t WS_END2 = WS_XB + 64 * MiB;
constexpr int CW_WMAX = 3600;
constexpr int CW_QPRO = 3520;
constexpr int CW_RANK = 4096;
constexpr int LDS_BYTES = 163840, MISC_OFF = LDS_BYTES - 256;

#define GAS __attribute__((address_space(1)))
#define LAS __attribute__((address_space(3)))
typedef unsigned short bf16;
typedef unsigned v4u __attribute__((ext_vector_type(4)));
typedef unsigned v2u __attribute__((ext_vector_type(2)));
typedef float f32x4 __attribute__((ext_vector_type(4)));
typedef float f32x2 __attribute__((ext_vector_type(2)));
typedef float f32x16 __attribute__((ext_vector_type(16)));
typedef short bf16x8 __attribute__((ext_vector_type(8)));
typedef short s16x4 __attribute__((ext_vector_type(4)));
typedef __bf16 bf16x2 __attribute__((ext_vector_type(2)));
#define MFMA32(a, b, c) __builtin_amdgcn_mfma_f32_32x32x16_bf16((a), (b), (c), 0, 0, 0)
#define MFMA16(a, b, c) __builtin_amdgcn_mfma_f32_16x16x32_bf16((a), (b), (c), 0, 0, 0)
using pg8::cvt_pk_bf16; using pg8::gelu_pk; using pg8::sigm; using pg8::bf_lo; using pg8::bf_hi;
__device__ __forceinline__ float wave_sum(float v) {
#pragma unroll
    for (int o = 1; o < 64; o <<= 1) v += __shfl_xor(v, o);
    return v;
}
__device__ __forceinline__ float dot2(unsigned a, unsigned b, float c) { return __builtin_amdgcn_fdot2_f32_bf16(__builtin_bit_cast(bf16x2, a), __builtin_bit_cast(bf16x2, b), c, false); }
__device__ __forceinline__ float gelu1(float v) { const f32x2 r = gelu_pk((f32x2){v, 0.f}); return r.x; }

#define XB_TMO      128
#define XB_XCNT(j)  (256  + 64 * (j))
#define XB_XSUB(j)  (1280 + 64 * (j))
#define XB_XGEN(j)  (2304 + 64 * (j))
#define XB_TOP      3328
#define XB_TOPGEN   3392
#define XCD_BAR_WORDS 3456
#define XB_SPIN_CAP (1u << 18)

__device__ __forceinline__ unsigned xb_ld(unsigned* p)              { return __hip_atomic_load(p, __ATOMIC_RELAXED, __HIP_MEMORY_SCOPE_AGENT); }
__device__ __forceinline__ unsigned xb_add(unsigned* p, unsigned v) { return __hip_atomic_fetch_add(p, v, __ATOMIC_RELAXED, __HIP_MEMORY_SCOPE_AGENT); }
__device__ __forceinline__ unsigned xb_xcc_id() { return (unsigned)__builtin_amdgcn_s_getreg((3 << 11) | 20) & 0xFu; }
#define XB_SPIN(cond, bar) do { unsigned _sp = 0; while (cond) { __builtin_amdgcn_s_sleep(1); \
    if ((++_sp & 255u) == 0u) { if (xb_ld(&(bar)[XB_TMO])) break; if (_sp > XB_SPIN_CAP) { atomicAdd(&(bar)[XB_TMO], 1u); break; } } } } while (0)

struct XcdBarrier {
    unsigned* bar; unsigned x;
    volatile LAS unsigned* st;
};

__device__ __forceinline__ XcdBarrier xcd_barrier_post(unsigned* bar, volatile LAS unsigned* st) {
    XcdBarrier b; b.bar = bar; b.x = xb_xcc_id(); b.st = st;
    if (threadIdx.x == 0) (void)xb_add(&bar[XB_XCNT(b.x)], 1u);
    return b;
}
__device__ __forceinline__ void xcd_barrier_complete(unsigned* bar, unsigned x, unsigned& nloc, unsigned& nx) {
    const unsigned G = gridDim.x * gridDim.y * gridDim.z;
    unsigned sum, cnt, mine, sp = 0u;
    for (;;) {
        sum = 0u; cnt = 0u; mine = 0u;
#pragma unroll
        for (unsigned j = 0; j < 16; ++j) { const unsigned c = xb_ld(&bar[XB_XCNT(j)]); sum += c; cnt += (c > 0u) ? 1u : 0u; mine = (j == x) ? c : mine; }
        if (sum == G) break;
        __builtin_amdgcn_s_sleep(1);
        if ((++sp & 255u) == 0u) { if (xb_ld(&bar[XB_TMO])) break; if (sp > XB_SPIN_CAP) { atomicAdd(&bar[XB_TMO], 1u); break; } }
    }
    nloc = mine > 0u ? mine : 1u; nx = cnt > 0u ? cnt : 1u;
}

__device__ __forceinline__ void xcd_barrier(const XcdBarrier& b) {
    asm volatile("s_waitcnt vmcnt(0)" ::: "memory");
    __syncthreads();
    if (threadIdx.x == 0) {
        unsigned* bar = b.bar;
        __builtin_amdgcn_s_waitcnt(0);
        unsigned nloc = b.st[0], nx = b.st[1];
        if (nloc == 0u) { xcd_barrier_complete(bar, b.x, nloc, nx); b.st[0] = nloc; b.st[1] = nx; }
        const unsigned old = xb_add(&bar[XB_XSUB(b.x)], 1u);
        const unsigned gen = old / nloc;
        if (old + 1u == (gen + 1u) * nloc) {
            __builtin_amdgcn_fence(__ATOMIC_RELEASE, "agent");
            asm volatile("s_waitcnt vmcnt(0)" ::: "memory");
            const unsigned og = xb_add(&bar[XB_TOP], 1u);
            const unsigned tg = og / nx;
            if (og + 1u == (tg + 1u) * nx) xb_add(&bar[XB_TOPGEN], 1u);
            else XB_SPIN(xb_ld(&bar[XB_TOPGEN]) == tg, bar);
            __builtin_amdgcn_fence(__ATOMIC_ACQUIRE, "agent");
            xb_add(&bar[XB_XGEN(b.x)], 1u);
            asm volatile("s_waitcnt vmcnt(0)" ::: "memory");
        } else {
            XB_SPIN(xb_ld(&bar[XB_XGEN(b.x)]) == gen, bar);
            __builtin_amdgcn_fence(__ATOMIC_ACQUIRE, "agent");
            asm volatile("s_waitcnt vmcnt(0)" ::: "memory");
        }
    }
    __syncthreads();
}

#ifndef SSM_LDS_STATE
#define SSM_LDS_STATE 1
#endif
#ifndef PEER_DEFER
#define PEER_DEFER 1
#endif
#ifndef WCOL
#define WCOL 1
#endif
struct Args { const float* in[24]; float* out; unsigned char* ws; int ph_lo, ph_hi; };

__device__ __forceinline__ void p0_transpose_item(const float* W, int K, int N, bf16* WT, LAS float* scr, int item, int lane) {
    const int nblk = N / 32, kb = item / nblk, nb = item % nblk, k0 = 64 * kb, n0 = 32 * nb;
#pragma unroll 8
    for (int i = 0; i < 32; ++i) { const int kk = 2 * i + (lane >> 5); scr[kk * 33 + (lane & 31)] = W[(size_t)(k0 + kk) * N + n0 + (lane & 31)]; }
    asm volatile("s_waitcnt lgkmcnt(0)" ::: "memory");
    const int c = lane & 7;
#pragma unroll
    for (int j = 0; j < 4; ++j) { const int n = (lane >> 3) + 8 * j; const LAS float* s = scr + (8 * c) * 33 + n;
        v4u o; o.x = cvt_pk_bf16(s[0 * 33], s[1 * 33]); o.y = cvt_pk_bf16(s[2 * 33], s[3 * 33]); o.z = cvt_pk_bf16(s[4 * 33], s[5 * 33]); o.w = cvt_pk_bf16(s[6 * 33], s[7 * 33]);
        *(v4u*)(WT + (size_t)(n0 + n) * K + k0 + 8 * c) = o; }
    asm volatile("s_waitcnt lgkmcnt(0)" ::: "memory");
}
__device__ __forceinline__ void cvt8(const float* src, bf16* dst, size_t i8) {
    const f32x4 a = *(const f32x4*)(src + i8 * 8), b = *(const f32x4*)(src + i8 * 8 + 4);
    v4u o; o.x = cvt_pk_bf16(a[0], a[1]); o.y = cvt_pk_bf16(a[2], a[3]); o.z = cvt_pk_bf16(b[0], b[1]); o.w = cvt_pk_bf16(b[2], b[3]);
    *(v4u*)(dst + i8 * 8) = o;
}
__device__ __forceinline__ unsigned pack_i8(float a, float b, float c, float d) {
    const int ia = (int)rintf(a), ib = (int)rintf(b), ic = (int)rintf(c), id = (int)rintf(d);
    return ((unsigned)ia & 255u) | (((unsigned)ib & 255u) << 8) | (((unsigned)ic & 255u) << 16) | ((unsigned)id << 24);
}
__device__ __forceinline__ void ssm_tables_item(const Args& a, LAS unsigned char* lds, int l, int g, int tid) {
    LAS float* apow = (LAS float*)(lds); LAS float* bbar = (LAS float*)(lds + 8704); LAS float* cm = (LAS float*)(lds + 16896); LAS float* Km = (LAS float*)(lds + 25088);
    const int lg = l * 64 + g;
    if (tid < 64) {
        const int p = tid;
        const float dt = expf(a.in[9][lg]); const float lr = a.in[7][lg * 64 + p], li = a.in[8][lg * 64 + p];
        for (int k = 0; k <= 16; ++k) { const float mg = expf(lr * dt * (float)k), ang = li * dt * (float)k; apow[(k * 64 + p) * 2] = mg * cosf(ang); apow[(k * 64 + p) * 2 + 1] = mg * sinf(ang); }
        const float mg1 = expf(lr * dt), ar = mg1 * cosf(li * dt), ai = mg1 * sinf(li * dt);
        const float inv = 1.0f / (lr * lr + li * li);
        const float cr = ((ar - 1.0f) * lr + ai * li) * inv, ci = (ai * lr - (ar - 1.0f) * li) * inv;
        for (int c = 0; c < 16; ++c) { const float br = a.in[10][(size_t)(lg * 64 + p) * 16 + c], bi = a.in[11][(size_t)(lg * 64 + p) * 16 + c];
            bbar[(p * 16 + c) * 2] = cr * br - ci * bi; bbar[(p * 16 + c) * 2 + 1] = cr * bi + ci * br; }
        float* A16 = (float*)(a.ws + WS_A16);
        { const float mg = expf(lr * dt * 16.0f), ang = li * dt * 16.0f; A16[(lg * 64 + p) * 2] = mg * cosf(ang); A16[(lg * 64 + p) * 2 + 1] = mg * sinf(ang); }
    }
    for (int i = tid; i < 1024; i += NTHR) { cm[i * 2] = a.in[12][(size_t)lg * 1024 + i]; cm[i * 2 + 1] = a.in[13][(size_t)lg * 1024 + i]; }
    __syncthreads();
    for (int i = tid; i < 4096; i += NTHR) { const int tau = i >> 8, c = (i >> 4) & 15, cp = i & 15; float s = 0.f;
        for (int p = 0; p < 64; ++p) { const float cr = cm[(c * 64 + p) * 2], ci = cm[(c * 64 + p) * 2 + 1], ar = apow[(tau * 64 + p) * 2], ai = apow[(tau * 64 + p) * 2 + 1];
            const float zr = cr * ar - ci * ai, zi = cr * ai + ci * ar; s += zr * bbar[(p * 16 + cp) * 2] - zi * bbar[(p * 16 + cp) * 2 + 1]; }
        if (tau == 0 && c == cp) s += a.in[14][l * 1024 + g * 16 + c];
        Km[i] = s; }
    __syncthreads();
    bf16* TF = (bf16*)(a.ws + WS_TF) + (size_t)lg * 16 * 512;
    for (int i = tid; i < 16 * 512; i += NTHR) { const int li_ = i >> 9, ln = (i >> 3) & 63, j = i & 7, r = ln & 31, h = ln >> 5; const int tau = li_ - 1 + (r >> 4);
        const float v = (tau >= 0 && tau < 16) ? Km[(tau * 16 + (r & 15)) * 16 + 8 * h + j] : 0.f; TF[i] = (bf16)(cvt_pk_bf16(v, 0.f) & 0xffffu); }
    bf16* WF = (bf16*)(a.ws + WS_WF) + (size_t)lg * 64 * 512;
    for (int i = tid; i < 64 * 512; i += NTHR) { const int f = i >> 9, ti = f >> 3, kk = f & 7, ln = (i >> 3) & 63, j = i & 7, r = ln & 31, h = ln >> 5;
        const int t = 2 * ti + (r >> 4), c = r & 15, rho = 16 * kk + 8 * h + j, p = rho >> 1, ri = rho & 1;
        const float cr = cm[(c * 64 + p) * 2], ci = cm[(c * 64 + p) * 2 + 1], ar = apow[((t + 1) * 64 + p) * 2], ai = apow[((t + 1) * 64 + p) * 2 + 1];
        const float zr = cr * ar - ci * ai, zi = cr * ai + ci * ar; const float v = ri ? -zi : zr; WF[i] = (bf16)(cvt_pk_bf16(v, 0.f) & 0xffffu); }
    bf16* BF = (bf16*)(a.ws + WS_BF) + (size_t)lg * 64 * 512;
    for (int i = tid; i < 64 * 512; i += NTHR) { const int f = i >> 9, q = f >> 4, s = f & 15, ln = (i >> 3) & 63, j = i & 7, r = ln & 31, h = ln >> 5;
        const int rho = 32 * q + r, p = rho >> 1, ri = rho & 1, cp = 8 * h + j;
        const float ar = apow[((15 - s) * 64 + p) * 2], ai = apow[((15 - s) * 64 + p) * 2 + 1], br = bbar[(p * 16 + cp) * 2], bi = bbar[(p * 16 + cp) * 2 + 1];
        const float zr = ar * br - ai * bi, zi = ar * bi + ai * br; const float v = ri ? zi : zr; BF[i] = (bf16)(cvt_pk_bf16(v, 0.f) & 0xffffu); }
    __syncthreads();
}
__device__ __forceinline__ void win_absmax(const Args& a, int tid, int lane);
template <int KPL, bool I8> __device__ __forceinline__ void wconv_item(const float* W, int N, int n0, unsigned char* WT, float* wsc, LAS float* red, int lane, int wave) {
    constexpr int K = KPL * 16;
    const int col = lane & 31, kb = wave * (2 * KPL) + (lane >> 5) * KPL;
    const float* src = W + (size_t)kb * N + n0 + col;
    float v[KPL]; float mx = 0.f;
#pragma unroll
    for (int i = 0; i < KPL; ++i) v[i] = src[(size_t)i * N];
#pragma unroll
    for (int i = 0; i < KPL; ++i) mx = fmaxf(mx, fabsf(v[i]));
    mx = fmaxf(mx, __shfl_xor(mx, 32));
    if (lane < 32) red[wave * 32 + lane] = mx;
    __syncthreads();
    float cm = 0.f;
#pragma unroll
    for (int w = 0; w < 8; ++w) cm = fmaxf(cm, red[w * 32 + col]);
    const float top = I8 ? 127.0f : 400.0f; const float q = cm > 0.f ? top / cm : 1.0f;
    if (wave == 0 && lane < 32) wsc[n0 + col] = cm > 0.f ? cm / top : 1.0f;
    unsigned char* dst = WT + (size_t)(n0 + col) * K + kb;
#pragma unroll
    for (int j = 0; j < KPL / 16; ++j) { unsigned w[4];
#pragma unroll
        for (int e = 0; e < 4; ++e) { const float x0 = v[16 * j + 4 * e] * q, x1 = v[16 * j + 4 * e + 1] * q, x2 = v[16 * j + 4 * e + 2] * q, x3 = v[16 * j + 4 * e + 3] * q;
            if (I8) w[e] = pack_i8(x0, x1, x2, x3);
            else { int t = __builtin_amdgcn_cvt_pk_fp8_f32(x0, x1, 0, false); t = __builtin_amdgcn_cvt_pk_fp8_f32(x2, x3, t, true); w[e] = (unsigned)t; } }
        *(v4u*)(dst + 16 * j) = (v4u){w[0], w[1], w[2], w[3]}; }
    __syncthreads();
}
__device__ __forceinline__ void wconv_all(const Args& a, LAS unsigned char* lds, int lane, int wave) {
    LAS float* red = (LAS float*)lds; float* WSC = (float*)(a.ws + WS_WSC);
    for (int it = blockIdx.x; it < (WQ_I8 ? 1024 : 896); it += gridDim.x) {
        if (it >= 896) { const int j = it - 896, l = j >> 6, nb = j & 63; wconv_item<128, true>(a.in[19] + (size_t)l * D * D, D, 32 * nb, a.ws + WS_WQ + (size_t)l * D * D, WSC + l * WSC_L + WSC_WQ, red, lane, wave); }
        else if (it < 512) { const int l = it >> 8, nb = it & 255; wconv_item<128, true>(a.in[6] + (size_t)l * D * INC, INC, 32 * nb, a.ws + WS_WIN + (size_t)l * INC * D, WSC + l * WSC_L + WSC_IN, red, lane, wave); }
        else if (it >= 640 && it < 768) { const int j = it - 640, l = j >> 6, nb = j & 63; wconv_item<128, false>(a.in[18] + (size_t)l * D * D, D, 32 * nb, a.ws + WS_WOUT + (size_t)l * D * D, WSC + l * WSC_L + WSC_OUT, red, lane, wave); }
        else { const int j = it < 640 ? it - 512 : 128 + (it - 768); const int l = j >> 7, wh = (j >> 6) & 1, nb = j & 63;
            wconv_item<64, false>((wh ? a.in[17] : a.in[16]) + (size_t)l * 1024 * D, D, 32 * nb, a.ws + (wh ? WS_WBRA : WS_WBRS) + (size_t)l * D * 1024, WSC + l * WSC_L + (wh ? WSC_BRA : WSC_BRS), red, lane, wave); }
    }
}
__device__ __forceinline__ void peer_conv_row(const Args& a, int tab, int row, int lane) {
    float* DS = (float*)(a.ws + WS_DS);
    const float* src = (tab ? a.in[22] : a.in[21]) + (size_t)row * D + 4 * lane;
    f32x4 v[8]; float mx = 0.f;
#pragma unroll
    for (int j = 0; j < 8; ++j) { v[j] = *(const f32x4*)(src + 256 * j); mx = fmaxf(mx, fmaxf(fmaxf(fabsf(v[j][0]), fabsf(v[j][1])), fmaxf(fabsf(v[j][2]), fabsf(v[j][3])))); }
#pragma unroll
    for (int o = 1; o < 64; o <<= 1) mx = fmaxf(mx, __shfl_xor(mx, o));
    const float sc = mx > 0.f ? 127.0f / mx : 1.0f;
    if (lane == 0) DS[(size_t)tab * DEPTH * NE + row] = mx > 0.f ? mx * (1.0f / 127.0f) : 1.0f;
    unsigned char* dstb = (tab ? a.ws + WS_PV : a.ws + WS_PU) + (size_t)(row / NE) * NE * D + (size_t)(row % NE) * 128;
#pragma unroll
    for (int j = 0; j < 8; ++j) { const unsigned w = pack_i8(v[j][0] * sc, v[j][1] * sc, v[j][2] * sc, v[j][3] * sc);
        const int bo = 4 * (lane + 64 * j); *(unsigned*)(dstb + (size_t)(bo >> 7) * NE * 128 + (bo & 127)) = w; }
}
__device__ __forceinline__ void peer_conv_row2(const Args& a, int tab, int row, int lane) {
    float* DS = (float*)(a.ws + WS_DS);
    const float* src = (tab ? a.in[22] : a.in[21]) + (size_t)row * D + 4 * lane;
    f32x4 v[2][8]; float mx[2] = {0.f, 0.f};
#pragma unroll
    for (int r = 0; r < 2; ++r)
#pragma unroll
        for (int j = 0; j < 8; ++j) v[r][j] = __builtin_nontemporal_load((const f32x4*)(src + (size_t)r * D + 256 * j));
#pragma unroll
    for (int r = 0; r < 2; ++r) {
#pragma unroll
        for (int j = 0; j < 8; ++j) mx[r] = fmaxf(mx[r], fmaxf(fmaxf(fabsf(v[r][j][0]), fabsf(v[r][j][1])), fmaxf(fabsf(v[r][j][2]), fabsf(v[r][j][3]))));
#pragma unroll
        for (int o = 1; o < 64; o <<= 1) mx[r] = fmaxf(mx[r], __shfl_xor(mx[r], o)); }
#pragma unroll
    for (int r = 0; r < 2; ++r) { const int rw = row + r;
        const float sc = mx[r] > 0.f ? 127.0f / mx[r] : 1.0f;
        if (lane == 0) DS[(size_t)tab * DEPTH * NE + rw] = mx[r] > 0.f ? mx[r] * (1.0f / 127.0f) : 1.0f;
        unsigned char* dstb = (tab ? a.ws + WS_PV : a.ws + WS_PU) + (size_t)(rw / NE) * NE * D + (size_t)(rw % NE) * 128;
#pragma unroll
        for (int j = 0; j < 8; ++j) { const unsigned w = pack_i8(v[r][j][0] * sc, v[r][j][1] * sc, v[r][j][2] * sc, v[r][j][3] * sc);
            const int bo = 4 * (lane + 64 * j); __builtin_nontemporal_store(w, (unsigned*)(dstb + (size_t)(bo >> 7) * NE * 128 + (bo & 127))); } }
}
__device__ __forceinline__ void p0_prologue(const Args& a, LAS unsigned char* lds, int tid, int lane, int wave) {
    const int G = gridDim.x, bx = blockIdx.x;
    {
        LAS float* cact = (LAS float*)lds; LAS float* red = (LAS float*)(lds + 32768);
        for (int i = tid; i < NB * D; i += NTHR) { const float v = a.in[1][i]; cact[i] = v / (1.0f + __expf(-v)); }
        __syncthreads();
        float* modv = (float*)(a.ws + WS_MOD);
        for (int it = bx; it < 2 * (NMOD / 64); it += G) {
            const int l = it / (NMOD / 64), j0 = (it % (NMOD / 64)) * 64;
            const float* W = a.in[2] + ((size_t)l * D + wave * 256) * NMOD + j0 + lane;
            float a0 = 0.f, a1 = 0.f, a2 = 0.f, a3 = 0.f;
#pragma unroll 32
            for (int k = 0; k < 256; ++k) { const float w = W[(size_t)k * NMOD]; const int kk = wave * 256 + k; a0 += cact[kk] * w; a1 += cact[D + kk] * w; a2 += cact[2 * D + kk] * w; a3 += cact[3 * D + kk] * w; }
            red[(wave * 4 + 0) * 64 + lane] = a0; red[(wave * 4 + 1) * 64 + lane] = a1; red[(wave * 4 + 2) * 64 + lane] = a2; red[(wave * 4 + 3) * 64 + lane] = a3;
            __syncthreads();
            if (tid < 256) { const int b = tid >> 6; float s = a.in[3][l * NMOD + j0 + lane];
#pragma unroll
                for (int w = 0; w < 8; ++w) s += red[(w * 4 + b) * 64 + lane];
                modv[(size_t)(l * NB + b) * NMOD + j0 + lane] = s; }
            __syncthreads();
        }
    }
    for (int it = bx; it < DEPTH * 64; it += G) ssm_tables_item(a, lds, it >> 6, it & 63, tid);
    __syncthreads();
    {
        LAS float* scr = (LAS float*)(lds + 49152 + wave * 8704);
        const int gw = bx * NWAVES + wave, NGW = G * NWAVES;
        constexpr int I_GLU = 16 * 32, I_OUT = WQ_I8 ? 0 : 32 * 64, I_L = I_GLU + I_OUT;
        for (int it = gw; it < DEPTH * I_L; it += NGW) {
            const int l = it / I_L; int r = it % I_L;
            if (r < I_GLU) { p0_transpose_item(a.in[15] + (size_t)l * 1024 * 1024, 1024, 1024, (bf16*)(a.ws + WS_WGLU) + (size_t)l * 1024 * 1024, scr, r, lane); continue; } r -= I_GLU;
            if (!WQ_I8) p0_transpose_item(a.in[19] + (size_t)l * D * D, D, D, (bf16*)(a.ws + WS_WQ) + (size_t)l * D * D, scr, r, lane);
        }
    }
#if WCOL
    __syncthreads();
    wconv_all(a, lds, lane, wave);
#ifdef WCONV_TWICE
    wconv_all(a, lds, lane, wave);
#endif
#endif
    {
        const int gw = bx * NWAVES + wave, NGW = G * NWAVES;
        float* DS = (float*)(a.ws + WS_DS);
        unsigned* qhead = (unsigned*)(a.ws + WS_CTL) + CW_QPRO;
        constexpr int NL0 = PEER_DEFER ? 1 : DEPTH;
        for (;;) { unsigned c0 = 0; if (lane == 0) c0 = __hip_atomic_fetch_add(qhead, 1u, __ATOMIC_RELAXED, __HIP_MEMORY_SCOPE_AGENT); c0 = (unsigned)__builtin_amdgcn_readfirstlane((int)c0); if (c0 >= (unsigned)(2 * NL0 * NE / 16)) break;
        for (int rr = (int)c0 * 16; rr < (int)c0 * 16 + 16; rr += 2) { const int tab = rr >= NL0 * NE; peer_conv_row2(a, tab, rr - tab * NL0 * NE, lane); }
        }
        const size_t gt = (size_t)bx * NTHR + tid, GT = (size_t)G * NTHR;
        for (size_t i = gt; i < (size_t)(2 * 2 * 128 * 128 / 8); i += GT) cvt8(a.in[20], (bf16*)(a.ws + WS_SKB), i);
    }
#if !WCOL
    win_absmax(a, tid, lane);
#endif
}
template <int MODE> __device__ __forceinline__ void modnorm_core(f32x4 (&v)[8], const float* gain, const float* sc, const float* sh, bf16* orow, int lane, unsigned char* o8, float* hs);
template <int MODE, bool XBF = false> __device__ __forceinline__ void modnorm_row(const void* xrow_, const float* gain, const float* sc, const float* sh, bf16* orow, int lane, unsigned char* o8 = nullptr, float* hs = nullptr) {
    f32x4 v[8];
#pragma unroll
    for (int j = 0; j < 8; ++j) {
        if (XBF) { const v2u w = *(const v2u*)((const bf16*)xrow_ + 4 * lane + 256 * j); v[j] = (f32x4){bf_lo(w.x), bf_hi(w.x), bf_lo(w.y), bf_hi(w.y)}; } else v[j] = *(const f32x4*)((const float*)xrow_ + 4 * lane + 256 * j); }
    modnorm_core<MODE>(v, gain, sc, sh, orow, lane, o8, hs);
}
template <int MODE> __device__ __forceinline__ void modnorm_raw(const v2u (&raw)[8], const float* gain, const float* sc, const float* sh, bf16* orow, int lane, unsigned char* o8, float* hs) {
    f32x4 v[8];
#pragma unroll
    for (int j = 0; j < 8; ++j) v[j] = (f32x4){bf_lo(raw[j].x), bf_hi(raw[j].x), bf_lo(raw[j].y), bf_hi(raw[j].y)};
    modnorm_core<MODE>(v, gain, sc, sh, orow, lane, o8, hs);
}
__device__ __forceinline__ void modnorm_pre(const v2u (&raw)[8], const f32x4 (&gs)[8], const f32x4 (&shv)[8], int lane, unsigned char* o8, float* hs) {
    f32x4 v[8]; float s = 0.f;
#pragma unroll
    for (int j = 0; j < 8; ++j) { v[j] = (f32x4){bf_lo(raw[j].x), bf_hi(raw[j].x), bf_lo(raw[j].y), bf_hi(raw[j].y)}; s += (v[j][0] * v[j][0] + v[j][1] * v[j][1]) + (v[j][2] * v[j][2] + v[j][3] * v[j][3]); }
    const float rstd = 1.0f / sqrtf(wave_sum(s) * (1.0f / D) + EPS); float mx = 0.f;
#pragma unroll
    for (int j = 0; j < 8; ++j) { const f32x4 o = v[j] * rstd * gs[j] + shv[j]; v[j] = o; mx = fmaxf(mx, fmaxf(fmaxf(fabsf(o[0]), fabsf(o[1])), fmaxf(fabsf(o[2]), fabsf(o[3])))); }
#pragma unroll
    for (int o = 1; o < 64; o <<= 1) mx = fmaxf(mx, __shfl_xor(mx, o));
    const float q = mx > 0.f ? 127.0f / mx : 1.0f; if (lane == 0) *hs = mx > 0.f ? mx / 127.0f : 1.0f;
#pragma unroll
    for (int j = 0; j < 8; ++j) *(unsigned*)(o8 + 4 * lane + 256 * j) = pack_i8(v[j][0] * q, v[j][1] * q, v[j][2] * q, v[j][3] * q);
}
__device__ __forceinline__ void modnorm_pre_f(f32x4 (&v)[8], const f32x4 (&gs)[8], const f32x4 (&shv)[8], int lane, unsigned char* o8, float* hs) {
    float s = 0.f;
#pragma unroll
    for (int j = 0; j < 8; ++j) s += (v[j][0] * v[j][0] + v[j][1] * v[j][1]) + (v[j][2] * v[j][2] + v[j][3] * v[j][3]);
    const float rstd = 1.0f / sqrtf(wave_sum(s) * (1.0f / D) + EPS); float mx = 0.f;
#pragma unroll
    for (int j = 0; j < 8; ++j) { const f32x4 o = v[j] * rstd * gs[j] + shv[j]; v[j] = o; mx = fmaxf(mx, fmaxf(fmaxf(fabsf(o[0]), fabsf(o[1])), fmaxf(fabsf(o[2]), fabsf(o[3])))); }
#pragma unroll
    for (int o = 1; o < 64; o <<= 1) mx = fmaxf(mx, __shfl_xor(mx, o));
    const float q = mx > 0.f ? 127.0f / mx : 1.0f; if (lane == 0) *hs = mx > 0.f ? mx / 127.0f : 1.0f;
#pragma unroll
    for (int j = 0; j < 8; ++j) *(unsigned*)(o8 + 4 * lane + 256 * j) = pack_i8(v[j][0] * q, v[j][1] * q, v[j][2] * q, v[j][3] * q);
}
template <bool XBF> __device__ __forceinline__ void norm_rows8(const void* X, const float* gain, const float* modl, int sc_off, int sh_off, int lane, int wave, unsigned char* H8, float* HS) {
    const int gw = blockIdx.x * NWAVES + wave, NGW = gridDim.x * NWAVES;
    typedef typename std::conditional<XBF, v2u, f32x4>::type raw_t;
    for (int m0 = gw * 8; m0 < M; m0 += NGW * 8) {
        const float* mb = modl + (size_t)(m0 / SEQ) * NMOD;
        raw_t xr[8], xn[8];
#pragma unroll
        for (int j = 0; j < 8; ++j) xr[j] = *(const raw_t*)((const char*)X + ((size_t)m0 * D + 4 * lane + 256 * j) * (XBF ? 2 : 4));
        f32x4 gs[8], shv[8];
#pragma unroll
        for (int j = 0; j < 8; ++j) { const int c = 4 * lane + 256 * j; gs[j] = *(const f32x4*)(gain + c) * (*(const f32x4*)(mb + sc_off + c) + 1.0f); shv[j] = *(const f32x4*)(mb + sh_off + c); }
#pragma unroll 1
        for (int i = 0; i < 8; ++i) { const int m = m0 + i, mn = m0 + (i + 1 < 8 ? i + 1 : 7);
#pragma unroll
            for (int j = 0; j < 8; ++j) xn[j] = *(const raw_t*)((const char*)X + ((size_t)mn * D + 4 * lane + 256 * j) * (XBF ? 2 : 4));
            f32x4 v[8];
#pragma unroll
            for (int j = 0; j < 8; ++j) { if constexpr (XBF) v[j] = (f32x4){bf_lo(xr[j].x), bf_hi(xr[j].x), bf_lo(xr[j].y), bf_hi(xr[j].y)}; else v[j] = xr[j]; }
            modnorm_pre_f(v, gs, shv, lane, H8 + (size_t)m * D, HS + m);
#pragma unroll
            for (int j = 0; j < 8; ++j) xr[j] = xn[j]; }
    }
}
template <int MODE> __device__ __forceinline__ void modnorm_core(f32x4 (&v)[8], const float* gain, const float* sc, const float* sh, bf16* orow, int lane, unsigned char* o8, float* hs) {
    float s = 0.f;
#pragma unroll
    for (int j = 0; j < 8; ++j) s += (v[j][0] * v[j][0] + v[j][1] * v[j][1]) + (v[j][2] * v[j][2] + v[j][3] * v[j][3]);
    const float rstd = 1.0f / sqrtf(wave_sum(s) * (1.0f / D) + EPS); float mx = 0.f;
#pragma unroll
    for (int j = 0; j < 8; ++j) { const int c = 4 * lane + 256 * j; const f32x4 gn = *(const f32x4*)(gain + c), scv = *(const f32x4*)(sc + c), shv = *(const f32x4*)(sh + c);
        const f32x4 o = v[j] * rstd * gn * (scv + 1.0f) + shv; v[j] = o;
        if (MODE == 0 || MODE == 2) { v2u w; w.x = cvt_pk_bf16(o[0], o[1]); w.y = cvt_pk_bf16(o[2], o[3]); *(v2u*)(orow + c) = w; }
        if (MODE != 0) mx = fmaxf(mx, fmaxf(fmaxf(fabsf(o[0]), fabsf(o[1])), fmaxf(fabsf(o[2]), fabsf(o[3])))); }
    if (MODE != 0) {
#pragma unroll
        for (int o = 1; o < 64; o <<= 1) mx = fmaxf(mx, __shfl_xor(mx, o));
        const float top = MODE == 1 ? 400.0f : 127.0f;
        const float q = mx > 0.f ? top / mx : 1.0f; if (lane == 0) *hs = mx > 0.f ? mx / top : 1.0f;
#pragma unroll
        for (int j = 0; j < 8; ++j) { unsigned w;
            if (MODE == 1) { int t = __builtin_amdgcn_cvt_pk_fp8_f32(v[j][0] * q, v[j][1] * q, 0, false); t = __builtin_amdgcn_cvt_pk_fp8_f32(v[j][2] * q, v[j][3] * q, t, true); w = (unsigned)t; }
            else w = pack_i8(v[j][0] * q, v[j][1] * q, v[j][2] * q, v[j][3] * q);
            *(unsigned*)(o8 + 4 * lane + 256 * j) = w; }
    }
}
template <int MODE, bool XBF = false> __device__ __forceinline__ void norm_phase(const void* X, const float* gain, const float* modl, int sc_off, int sh_off, bf16* H, int lane, int wave, unsigned char* H8 = nullptr, float* HS = nullptr) {
    const int gw = blockIdx.x * NWAVES + wave, NGW = gridDim.x * NWAVES;
    for (int m = gw; m < M; m += NGW) { const float* mb = modl + (size_t)(m / SEQ) * NMOD; modnorm_row<MODE, XBF>(XBF ? (const void*)((const bf16*)X + (size_t)m * D) : (const void*)((const float*)X + (size_t)m * D), gain, mb + sc_off, mb + sh_off, (MODE == 1 || MODE == 3) ? nullptr : H + (size_t)m * D, lane, MODE != 0 ? H8 + (size_t)m * D : nullptr, MODE != 0 ? HS + m : nullptr); }
}
__device__ __forceinline__ void win_absmax(const Args& a, int tid, int lane) {
    const size_t gt = (size_t)blockIdx.x * NTHR + tid, GT = (size_t)gridDim.x * NTHR;
    for (int lw = 0; lw < DEPTH * 4; ++lw) { const int l = lw >> 2, wi = lw & 3;
        const size_t nel = wi == 0 ? (size_t)D * INC : wi == 3 ? (size_t)D * D : (size_t)1024 * D;
        const f32x4* W = (const f32x4*)((wi == 0 ? a.in[6] : wi == 1 ? a.in[16] : wi == 2 ? a.in[17] : a.in[18]) + (size_t)l * nel); float mx = 0.f;
        for (size_t i = gt; i < nel / 4; i += GT) { const f32x4 v = W[i]; mx = fmaxf(mx, fmaxf(fmaxf(fabsf(v[0]), fabsf(v[1])), fmaxf(fabsf(v[2]), fabsf(v[3])))); }
#pragma unroll
        for (int o = 1; o < 64; o <<= 1) mx = fmaxf(mx, __shfl_xor(mx, o));
        if (lane == 0) atomicMax((unsigned*)(a.ws + WS_CTL) + CW_WMAX + 64 * lw, __float_as_uint(mx)); }
}
__device__ __forceinline__ float wscale(const Args& a, int l, int wi) {
    const float wmax = __uint_as_float(__hip_atomic_load((unsigned*)(a.ws + WS_CTL) + CW_WMAX + 64 * (4 * l + wi), __ATOMIC_RELAXED, __HIP_MEMORY_SCOPE_AGENT)); return wmax > 0.f ? wmax * (wi == 0 ? 1.0f / 127.0f : 1.0f / 400.0f) : 1.0f; }
__device__ __forceinline__ void w_to_fp8(const Args& a, LAS unsigned char* lds, int lane, int wave) {
    LAS float* scr = (LAS float*)(lds + 49152 + wave * 8704);
    const int gw = blockIdx.x * NWAVES + wave, NGW = gridDim.x * NWAVES;
    constexpr int I0 = 32 * 256, I1 = 16 * 64, I3 = 32 * 64, I_L = I0 + 2 * I1 + I3;
    for (int it = gw; it < DEPTH * I_L; it += NGW) {
        const int l = it / I_L; int item = it % I_L; int wi = 0, K = D, N = INC; const float* W = a.in[6] + (size_t)l * D * INC; unsigned char* WT = a.ws + WS_WIN + (size_t)l * INC * D;
        if (item >= I0) { item -= I0; wi = 1; K = 1024; N = D; W = a.in[16] + (size_t)l * 1024 * D; WT = a.ws + WS_WBRS + (size_t)l * D * 1024;
            if (item >= I1) { item -= I1; wi = 2; W = a.in[17] + (size_t)l * 1024 * D; WT = a.ws + WS_WBRA + (size_t)l * D * 1024;
                if (item >= I1) { item -= I1; wi = 3; K = D; W = a.in[18] + (size_t)l * D * D; WT = a.ws + WS_WOUT + (size_t)l * D * D; } } }
        const int nblk = N / 32, kb = item / nblk, nb = item % nblk, k0 = 64 * kb, n0 = 32 * nb;
        const float q = 1.0f / wscale(a, l, wi);
#pragma unroll 8
        for (int i = 0; i < 32; ++i) { const int kk = 2 * i + (lane >> 5); scr[kk * 33 + (lane & 31)] = W[(size_t)(k0 + kk) * N + n0 + (lane & 31)]; }
        asm volatile("s_waitcnt lgkmcnt(0)" ::: "memory");
        const int c = lane & 7;
#pragma unroll
        for (int j = 0; j < 4; ++j) { const int n = (lane >> 3) + 8 * j; const LAS float* s = scr + (8 * c) * 33 + n;
            unsigned w0, w1;
            if (wi == 0) { w0 = pack_i8(s[0 * 33] * q, s[1 * 33] * q, s[2 * 33] * q, s[3 * 33] * q); w1 = pack_i8(s[4 * 33] * q, s[5 * 33] * q, s[6 * 33] * q, s[7 * 33] * q); }
            else { int t0 = __builtin_amdgcn_cvt_pk_fp8_f32(s[0 * 33] * q, s[1 * 33] * q, 0, false); t0 = __builtin_amdgcn_cvt_pk_fp8_f32(s[2 * 33] * q, s[3 * 33] * q, t0, true);
                int t1 = __builtin_amdgcn_cvt_pk_fp8_f32(s[4 * 33] * q, s[5 * 33] * q, 0, false); t1 = __builtin_amdgcn_cvt_pk_fp8_f32(s[6 * 33] * q, s[7 * 33] * q, t1, true); w0 = (unsigned)t0; w1 = (unsigned)t1; }
            *(v2u*)(WT + (size_t)(n0 + n) * K + k0 + 8 * c) = (v2u){w0, w1}; }
        asm volatile("s_waitcnt lgkmcnt(0)" ::: "memory");
    }
}

__device__ __forceinline__ void ssm_fused(const Args& a, LAS unsigned char* lds, int l, int tid, int lane, int wave) {
    const bf16* ZU = (const bf16*)(a.ws + WS_ZU); float* HLOC = (float*)(a.ws + WS_HLOC); bf16* HPREV = (bf16*)(a.ws + WS_HPREV); const float* A16 = (const float*)(a.ws + WS_A16); bf16* Y = (bf16*)(a.ws + WS_Y);
#if SSM_LDS_STATE
    constexpr int L_TF = 0, L_WF = 16384, L_BF = 16384 + 65536, L_ST = L_BF, ST_STR = 272, ST_WAVE = 32 * ST_STR, L_EX = L_ST + 8 * ST_WAVE;
    static_assert(L_EX + 8 * 64 * 8 <= MISC_OFF, "SSM LDS layout");
#else
    constexpr int L_BF = 0, L_TF = 65536, L_WF = 65536 + 16384;
#endif
    for (int it = blockIdx.x; it < 256; it += gridDim.x) {
        const int g = it >> 2, nb = it & 3;
        { const v4u* s0 = (const v4u*)(a.ws + WS_BF + (size_t)(l * 64 + g) * 65536); const v4u* s1 = (const v4u*)(a.ws + WS_TF + (size_t)(l * 64 + g) * 16384); const v4u* s2 = (const v4u*)(a.ws + WS_WF + (size_t)(l * 64 + g) * 65536);
          for (int i = tid; i < 4096; i += NTHR) ((LAS v4u*)(lds + L_BF))[i] = s0[i];
          for (int i = tid; i < 1024; i += NTHR) ((LAS v4u*)(lds + L_TF))[i] = s1[i];
          for (int i = tid; i < 4096; i += NTHR) ((LAS v4u*)(lds + L_WF))[i] = s2[i]; }
        const int n = nb * 256 + wave * 32 + (lane & 31), h = lane >> 5;
        const bf16* zu = UGM ? ZU + ((size_t)g * M + n * 16) * 16 + 8 * h : ZU + (size_t)(n * 16) * 1024 + g * 16 + 8 * h;
        bf16x8 uf[16];
#pragma unroll
        for (int s = 0; s < 16; ++s) uf[s] = *(const bf16x8*)(zu + (size_t)s * (UGM ? 16 : 1024));
        __syncthreads();
        {
            f32x16 acc[4];
#pragma unroll
            for (int q = 0; q < 4; ++q)
#pragma unroll
                for (int r = 0; r < 16; ++r) acc[q][r] = 0.f;
#pragma unroll
            for (int s = 0; s < 16; ++s)
#pragma unroll
                for (int q = 0; q < 4; ++q) { const bf16x8 af = *(const LAS bf16x8*)(lds + L_BF + ((q * 16 + s) * 64 + lane) * 16); acc[q] = MFMA32(af, uf[s], acc[q]); }
#if SSM_LDS_STATE
            __syncthreads();
            LAS unsigned char* st = lds + L_ST + wave * ST_WAVE + (lane & 31) * ST_STR;
#pragma unroll
            for (int q = 0; q < 4; ++q)
#pragma unroll
                for (int v = 0; v < 4; ++v) *(LAS v2u*)(st + (32 * q + 8 * v + 4 * h) * 2) = (v2u){cvt_pk_bf16(acc[q][4 * v], acc[q][4 * v + 1]), cvt_pk_bf16(acc[q][4 * v + 2], acc[q][4 * v + 3])};
            asm volatile("s_waitcnt lgkmcnt(0)" ::: "memory");
        }
#else
            float* hl = HLOC + ((size_t)g * 1024 + n) * 128;
#pragma unroll
            for (int q = 0; q < 4; ++q)
#pragma unroll
                for (int v = 0; v < 4; ++v) *(f32x4*)(hl + 32 * q + 8 * v + 4 * h) = (f32x4){acc[q][4 * v], acc[q][4 * v + 1], acc[q][4 * v + 2], acc[q][4 * v + 3]};
        }
        __builtin_amdgcn_fence(__ATOMIC_RELEASE, "workgroup"); __syncthreads(); __builtin_amdgcn_fence(__ATOMIC_ACQUIRE, "workgroup");
#endif
        {
            const int p = lane; const float ar = A16[((l * 64 + g) * 64 + p) * 2], ai = A16[((l * 64 + g) * 64 + p) * 2 + 1];
            const float* hl = HLOC + ((size_t)g * 1024 + nb * 256 + wave * 32) * 128 + 2 * p; bf16* hp = HPREV + ((size_t)g * 1024 + nb * 256 + wave * 32) * 128 + 2 * p;
            f32x2 v[32];
#if SSM_LDS_STATE
            LAS unsigned char* stw = lds + L_ST + wave * ST_WAVE + 4 * p; (void)hl; (void)hp;
#pragma unroll
            for (int j = 0; j < 32; ++j) { const unsigned w = *(const LAS unsigned*)(stw + j * ST_STR); v[j] = (f32x2){bf_lo(w), bf_hi(w)}; }
#else
#pragma unroll
            for (int j = 0; j < 32; ++j) v[j] = *(const f32x2*)(hl + (size_t)j * 128);
#endif
            float er = 0.f, ei = 0.f;
#pragma unroll
            for (int j = 0; j < 32; ++j) { const float nr = ar * er - ai * ei + v[j][0], ni = ar * ei + ai * er + v[j][1]; er = nr; ei = ni; }
            float Ar = ar, Ai = ai;
#pragma unroll
            for (int q = 0; q < 5; ++q) { const float nr = Ar * Ar - Ai * Ai, ni = 2.0f * Ar * Ai; Ar = nr; Ai = ni; }
#if SSM_LDS_STATE
            LAS f32x2* ex = (LAS f32x2*)(lds + L_EX);
#else
            LAS f32x2* ex = (LAS f32x2*)(lds + 147456);
#endif
            ex[wave * 64 + p] = (f32x2){er, ei};
            __syncthreads();
            float hr = 0.f, hi = 0.f;
            for (int u = 0; u < wave; ++u) { const f32x2 e = ex[u * 64 + p]; const float nr = Ar * hr - Ai * hi + e[0], ni = Ar * hi + Ai * hr + e[1]; hr = nr; hi = ni; }
#pragma unroll
#if SSM_LDS_STATE
            for (int j = 0; j < 32; ++j) { *(LAS unsigned*)(stw + j * ST_STR) = cvt_pk_bf16(hr, hi); const float nr = ar * hr - ai * hi + v[j][0], ni = ar * hi + ai * hr + v[j][1]; hr = nr; hi = ni; }
            asm volatile("s_waitcnt lgkmcnt(0)" ::: "memory");
        }
#else
            for (int j = 0; j < 32; ++j) { *(unsigned*)(hp + (size_t)j * 128) = cvt_pk_bf16(hr, hi); const float nr = ar * hr - ai * hi + v[j][0], ni = ar * hi + ai * hr + v[j][1]; hr = nr; hi = ni; }
        }
        __builtin_amdgcn_fence(__ATOMIC_RELEASE, "workgroup"); __syncthreads(); __builtin_amdgcn_fence(__ATOMIC_ACQUIRE, "workgroup");
#endif
        {
            bf16x8 hpf[8];
#if SSM_LDS_STATE
            const LAS unsigned char* st2 = lds + L_ST + wave * ST_WAVE + (lane & 31) * ST_STR + 16 * h;
#pragma unroll
            for (int kk = 0; kk < 8; ++kk) hpf[kk] = *(const LAS bf16x8*)(st2 + 32 * kk);
#else
            const bf16* hp = HPREV + ((size_t)g * 1024 + n) * 128 + 8 * h;
#pragma unroll
            for (int kk = 0; kk < 8; ++kk) hpf[kk] = *(const bf16x8*)(hp + 16 * kk);
#endif
#pragma unroll
            for (int ti = 0; ti < 8; ++ti) {
                f32x16 acc;
#pragma unroll
                for (int r = 0; r < 16; ++r) acc[r] = 0.f;
#pragma unroll
                for (int kk = 0; kk < 8; ++kk) { const bf16x8 af = *(const LAS bf16x8*)(lds + L_WF + ((ti * 8 + kk) * 64 + lane) * 16); acc = MFMA32(af, hpf[kk], acc); }
#pragma unroll
                for (int s = 0; s <= 2 * ti + 1; ++s) { const bf16x8 af = *(const LAS bf16x8*)(lds + L_TF + ((2 * ti - s + 1) * 64 + lane) * 16); acc = MFMA32(af, uf[s], acc); }
#pragma unroll
                for (int dt = 0; dt < 2; ++dt) { bf16* yrow = YGM ? Y + ((size_t)g * M + (n * 16 + 2 * ti + dt)) * 16 + 4 * h : Y + (size_t)(n * 16 + 2 * ti + dt) * 1024 + g * 16 + 4 * h;
#pragma unroll
                    for (int hh = 0; hh < 2; ++hh) { const int r0 = (2 * dt + hh) * 4;
                        const f32x2 ga = gelu_pk((f32x2){acc[r0], acc[r0 + 1]}), gb = gelu_pk((f32x2){acc[r0 + 2], acc[r0 + 3]});
                        v2u w; w.x = cvt_pk_bf16(ga.x, ga.y); w.y = cvt_pk_bf16(gb.x, gb.y); *(v2u*)(yrow + 8 * hh) = w; } }
            }
        }
        __syncthreads();
    }
}
#ifndef XB_NT_ST
#define XB_NT_ST 0
#endif
#ifndef PEER_VMFMA
#define PEER_VMFMA 1
#endif
struct PeerMap { int fast, x, r; };
__device__ __forceinline__ int attn_item(const PeerMap& pm, int k) {
    if (pm.fast) { if (k >= 12) return -1; const int pair = 4 * pm.x + k / 3, j = pm.r + 32 * (k % 3); return ((j >> 5) << 10) | ((pair >> 3) << 8) | ((pair & 7) << 5) | (j & 31); }
    const int idx = (int)blockIdx.x + k * (int)gridDim.x; return idx < 3072 ? idx : -1;
}
constexpr int AT_KSTR = 272, AT_VSTR = 288, AT_VOFF = 256 * AT_KSTR;
__device__ __forceinline__ s16x4 tr_read(const LAS unsigned char* p) { typedef short v4i16_t __attribute__((ext_vector_type(4))); return __builtin_bit_cast(s16x4, __builtin_amdgcn_ds_read_tr16_b64_v4i16((LAS v4i16_t*)p)); }
#define AT_DECODE(idx_, p_, b_, hh_, d_, r_, n_) do { p_ = (idx_) >> 10; const int rem_ = (idx_) & 1023; b_ = rem_ >> 8; hh_ = (rem_ >> 5) & 7; \
        const int w5_ = ((rem_ & 31) + 8 * (b_) * (p_)) & 31;        \
        d_ = 2 * p_; r_ = w5_ & ((1 << d_) - 1); n_ = w5_ >> d_; } while (0)
#define AT_LOAD(REG, coff_, b_, hh_, d_, r_, n_) do { _Pragma("unroll") for (int i8 = 0; i8 < 8; ++i8) { const int i_ = tid + i8 * NTHR, j_ = i_ >> 4, ch_ = i_ & 15; int sub_ = 128 * ((n_) - 1) + j_; sub_ = sub_ < 0 ? 0 : sub_; \
        REG[i8] = *(const v4u*)((coff_) + ((size_t)(((b_) << 12) + (sub_ << (d_)) + (r_)) << 10) + ((hh_) << 7) + (ch_ << 3)); } } while (0)
#define AT_STORE(REG, base_, str_) do { _Pragma("unroll") for (int i8 = 0; i8 < 8; ++i8) { const int i_ = tid + i8 * NTHR, j_ = i_ >> 4, ch_ = i_ & 15; *(LAS v4u*)(lds + (base_) + (j_ << 8) + j_ * ((str_) - 256) + (ch_ << 4)) = REG[i8]; } } while (0)
#define AT_LOADQ(QF, b_, hh_, d_, r_, n_) do { const bf16* qrow_ = ZQ + ((size_t)(((b_) << 12) + ((128 * (n_) + 16 * wave + ii) << (d_)) + (r_)) << 10) + ((hh_) << 7) + 8 * g4; \
        _Pragma("unroll") for (int s_ = 0; s_ < 4; ++s_) QF[s_] = *(const bf16x8*)(qrow_ + 32 * s_); } while (0)
__device__ __forceinline__ void attn_phase(const Args& a, LAS unsigned char* lds, const PeerMap& pm, int tid, int lane, int wave) {
    const bf16* ZQ = (const bf16*)(a.ws + WS_ZQ); const bf16* ZK = (const bf16*)(a.ws + WS_ZK); const bf16* ZV = (const bf16*)(a.ws + WS_ZV); bf16* OB = (bf16*)(a.ws + WS_OB); float* LSE = (float*)(a.ws + WS_LSE);
    const int ii = lane & 15, g4 = lane >> 4;
    { unsigned zz = 0u; asm volatile("" : "+v"(zz));
      for (int i = tid; i < 16 * AT_VSTR / 16; i += NTHR) *(LAS v4u*)(lds + AT_VOFF + 256 * AT_VSTR + i * 16) = (v4u){zz, zz, zz, zz}; }
    int kit = 0; int idx = attn_item(pm, 0); if (idx < 0) return;
    int p, b, hh, d, r, n; AT_DECODE(idx, p, b, hh, d, r, n);
    v4u kreg[8], vreg[8]; bf16x8 qf[4];
    AT_LOAD(kreg, ZK, b, hh, d, r, n); AT_LOAD(vreg, ZV, b, hh, d, r, n); AT_LOADQ(qf, b, hh, d, r, n);
    AT_STORE(kreg, 0, AT_KSTR);
#pragma unroll 1
    for (;;) {
        const int idn = attn_item(pm, kit + 1); const bool more = idn >= 0;
        int pN, bN, hhN, dN, rN, nN; AT_DECODE(more ? idn : idx, pN, bN, hhN, dN, rN, nN);
        __syncthreads();
        AT_STORE(vreg, AT_VOFF, AT_VSTR);
        AT_LOAD(kreg, ZK, bN, hhN, dN, rN, nN);
        const int tq = (b << 12) + ((128 * n + 16 * wave + ii) << d) + r;
        const int kb_lo = (n == 0) ? 8 : wave;
        f32x4 sc[9];
#pragma unroll
        for (int bi = 0; bi < 9; ++bi) { const int kb = wave + bi;
            f32x4 acc = (f32x4){0.f, 0.f, 0.f, 0.f};
            if (kb >= kb_lo) {
#pragma unroll
                for (int s = 0; s < 4; ++s) { const bf16x8 kf = *(const LAS bf16x8*)(lds + (16 * kb + ii) * AT_KSTR + (32 * s + 8 * g4) * 2); acc = MFMA16(kf, qf[s], acc); }
            }
#pragma unroll
            for (int rg = 0; rg < 4; ++rg) { const int jj = 4 * g4 + rg; bool ok = kb >= kb_lo; if (bi == 0) ok = ok && (jj >= ii); if (bi == 8) ok = ok && (jj <= ii); sc[bi][rg] = ok ? acc[rg] : -1e30f; }
        }
        float mx = -1e30f;
#pragma unroll
        for (int bi = 0; bi < 9; ++bi)
#pragma unroll
            for (int rg = 0; rg < 4; ++rg) mx = fmaxf(mx, sc[bi][rg]);
        mx = fmaxf(mx, __shfl_xor(mx, 16)); mx = fmaxf(mx, __shfl_xor(mx, 32));
        const float c2 = 0.08838834764831845f * 1.4426950408889634f;
        float lsum = 0.f;
#pragma unroll
        for (int bi = 0; bi < 9; ++bi)
#pragma unroll
            for (int rg = 0; rg < 4; ++rg) { const float pv = __builtin_amdgcn_exp2f((sc[bi][rg] - mx) * c2); sc[bi][rg] = pv; lsum += pv; }
        lsum += __shfl_xor(lsum, 16); lsum += __shfl_xor(lsum, 32);
        bf16x8 pf[5];
#pragma unroll
        for (int ks = 0; ks < 5; ++ks) { v4u w; w.x = cvt_pk_bf16(sc[2 * ks][0], sc[2 * ks][1]); w.y = cvt_pk_bf16(sc[2 * ks][2], sc[2 * ks][3]);
            if (ks < 4) { w.z = cvt_pk_bf16(sc[2 * ks + 1][0], sc[2 * ks + 1][1]); w.w = cvt_pk_bf16(sc[2 * ks + 1][2], sc[2 * ks + 1][3]); } else { w.z = 0u; w.w = 0u; }
            pf[ks] = __builtin_bit_cast(bf16x8, w); }
        __syncthreads();
        AT_STORE(kreg, 0, AT_KSTR);
        AT_LOAD(vreg, ZV, bN, hhN, dN, rN, nN); AT_LOADQ(qf, bN, hhN, dN, rN, nN);
        f32x4 oacc[8];
#pragma unroll
        for (int eb = 0; eb < 8; ++eb) oacc[eb] = (f32x4){0.f, 0.f, 0.f, 0.f};
#pragma unroll
        for (int ks = 0; ks < 5; ++ks) {
            if (wave + 2 * ks + 1 >= kb_lo) {
                const LAS unsigned char* vb = lds + AT_VOFF + (16 * (wave + 2 * ks) + 4 * g4 + (ii >> 2)) * AT_VSTR + 4 * (ii & 3) * 2;
#pragma unroll
                for (int eb = 0; eb < 8; ++eb) { const s16x4 lo = tr_read(vb + eb * 32), hi = tr_read(vb + 16 * AT_VSTR + eb * 32);
                    const bf16x8 af = (bf16x8){lo[0], lo[1], lo[2], lo[3], hi[0], hi[1], hi[2], hi[3]}; oacc[eb] = MFMA16(af, pf[ks], oacc[eb]); }
            }
        }
        const float inv = 1.0f / lsum;
        bf16* orow = OB + ((size_t)p * M + tq) * 1024 + hh * 128 + 4 * g4;
#pragma unroll
        for (int eb = 0; eb < 8; ++eb) { v2u w; w.x = cvt_pk_bf16(oacc[eb][0] * inv, oacc[eb][1] * inv); w.y = cvt_pk_bf16(oacc[eb][2] * inv, oacc[eb][3] * inv); *(v2u*)(orow + 16 * eb) = w; }
        if (g4 == 0) LSE[((size_t)p * M + tq) * 8 + hh] = mx * 0.08838834764831845f + __logf(lsum);
        if (!more) break;
        idx = idn; ++kit; p = pN; b = bN; hh = hhN; d = dN; r = rN; n = nN;
    }
    __syncthreads();
}
constexpr float YA_Q = 8.0f, MG_Q = 4.0f;
__device__ __forceinline__ void attn_combine(const Args& a, int tid) {
    const bf16* OB = (const bf16*)(a.ws + WS_OB); const float* LSE = (const float*)(a.ws + WS_LSE); unsigned char* YA8 = a.ws + WS_YA;
    const size_t gt = (size_t)blockIdx.x * NTHR + tid, GT = (size_t)gridDim.x * NTHR;
    for (size_t i0 = gt; i0 < (size_t)M * 128; i0 += 4 * GT) {
        float l0[4], l1[4], l2[4]; v4u o0[4], o1[4], o2[4];
#pragma unroll
        for (int u = 0; u < 4; ++u) { size_t i = i0 + (size_t)u * GT; if (i >= (size_t)M * 128) i = i0; const size_t t = i >> 7; const int ch = (int)(i & 127), hh = ch >> 4;
            l0[u] = LSE[(0 * (size_t)M + t) * 8 + hh]; l1[u] = LSE[(1 * (size_t)M + t) * 8 + hh]; l2[u] = LSE[(2 * (size_t)M + t) * 8 + hh];
            o0[u] = *(const v4u*)(OB + (0 * (size_t)M + t) * 1024 + ch * 8); o1[u] = *(const v4u*)(OB + (1 * (size_t)M + t) * 1024 + ch * 8); o2[u] = *(const v4u*)(OB + (2 * (size_t)M + t) * 1024 + ch * 8); }
#pragma unroll
        for (int u = 0; u < 4; ++u) { const size_t i = i0 + (size_t)u * GT; if (i >= (size_t)M * 128) break; const size_t t = i >> 7; const int ch = (int)(i & 127);
            const float mx = fmaxf(l0[u], fmaxf(l1[u], l2[u])); float w0 = __expf(l0[u] - mx), w1 = __expf(l1[u] - mx), w2 = __expf(l2[u] - mx); const float inv = 1.0f / (w0 + w1 + w2); w0 *= inv; w1 *= inv; w2 *= inv;
            float o[8];
#pragma unroll
            for (int k = 0; k < 4; ++k) { o[2 * k] = w0 * bf_lo(o0[u][k]) + w1 * bf_lo(o1[u][k]) + w2 * bf_lo(o2[u][k]); o[2 * k + 1] = w0 * bf_hi(o0[u][k]) + w1 * bf_hi(o1[u][k]) + w2 * bf_hi(o2[u][k]); }
            unsigned p0, p1; pg8::pk8_fp8(o, YA_Q, p0, p1);
            *(v2u*)(YA8 + t * 1024 + ch * 8) = (v2u){p0, p1}; }
    }
}

__device__ __forceinline__ unsigned f2ord(float f) { const unsigned u = __float_as_uint(f); return (u & 0x80000000u) ? ~u : (u | 0x80000000u); }
__device__ __forceinline__ float ord2f(unsigned k) { return __uint_as_float((k & 0x80000000u) ? (k ^ 0x80000000u) : ~k); }
__device__ __forceinline__ unsigned umax(unsigned a, unsigned b) { return a > b ? a : b; }
__device__ __forceinline__ unsigned umin(unsigned a, unsigned b) { return a < b ? a : b; }
__device__ __forceinline__ void sort16_desc(unsigned (&v)[16]) {
#define S16_CE(a_, b_) { const unsigned x_ = v[a_], y_ = v[b_]; v[a_] = umax(x_, y_); v[b_] = umin(x_, y_); }
    S16_CE(0, 13) S16_CE(1, 12) S16_CE(2, 15) S16_CE(3, 14) S16_CE(4, 8) S16_CE(5, 6) S16_CE(7, 11) S16_CE(9, 10)
    S16_CE(0, 5) S16_CE(1, 7) S16_CE(2, 9) S16_CE(3, 4) S16_CE(6, 13) S16_CE(8, 14) S16_CE(10, 15) S16_CE(11, 12)
    S16_CE(0, 1) S16_CE(2, 3) S16_CE(4, 5) S16_CE(6, 8) S16_CE(7, 9) S16_CE(10, 11) S16_CE(12, 13) S16_CE(14, 15)
    S16_CE(0, 2) S16_CE(1, 3) S16_CE(4, 10) S16_CE(5, 11) S16_CE(6, 7) S16_CE(8, 9) S16_CE(12, 14) S16_CE(13, 15)
    S16_CE(1, 2) S16_CE(3, 12) S16_CE(4, 6) S16_CE(5, 7) S16_CE(8, 10) S16_CE(9, 11) S16_CE(13, 14)
    S16_CE(1, 4) S16_CE(2, 6) S16_CE(5, 8) S16_CE(7, 10) S16_CE(9, 13) S16_CE(11, 14)
    S16_CE(2, 4) S16_CE(3, 6) S16_CE(9, 12) S16_CE(11, 13)
    S16_CE(3, 5) S16_CE(6, 8) S16_CE(7, 9) S16_CE(10, 12)
    S16_CE(3, 4) S16_CE(5, 6) S16_CE(7, 8) S16_CE(9, 10) S16_CE(11, 12)
    S16_CE(6, 7) S16_CE(8, 9)
#undef S16_CE
}
__device__ __forceinline__ void merge_top16(unsigned (&x)[16], const unsigned (&y)[16]) {
#pragma unroll
    for (int i = 0; i < 16; ++i) x[i] = umax(x[i], y[15 - i]);
#pragma unroll
    for (int j = 8; j > 0; j >>= 1)
#pragma unroll
        for (int i = 0; i < 16; ++i) { const int l = i ^ j; if (l > i) { const unsigned p = x[i], q = x[l]; x[i] = umax(p, q); x[l] = umin(p, q); } }
}
__device__ __forceinline__ void xmerge_top16(unsigned (&x)[16]) {
    unsigned y[16];
#pragma unroll
    for (int i = 0; i < 16; ++i) y[i] = (unsigned)__shfl_xor((int)x[i], 32);
    merge_top16(x, y);
}
constexpr int TK_SKSTR = 272, TK_HALF = 128 * TK_SKSTR, TK_SCR = 2 * TK_HALF, TK_IJ = TK_SCR + 8 * 1024;
__device__ __forceinline__ void topk_half(const LAS unsigned char* skb, const bf16* qrow, int lane, unsigned (&top)[16]) {
    const int r = lane & 31, hq = lane >> 5;
    bf16x8 qf[8];
#pragma unroll
    for (int ks = 0; ks < 8; ++ks) qf[ks] = *(const bf16x8*)(qrow + 16 * ks + 8 * hq);
#pragma unroll
    for (int kt = 0; kt < 4; ++kt) {
        f32x16 acc;
#pragma unroll
        for (int i = 0; i < 16; ++i) acc[i] = 0.f;
#pragma unroll
        for (int ks = 0; ks < 8; ++ks) { const bf16x8 af = *(const LAS bf16x8*)(skb + (32 * kt + r) * TK_SKSTR + (16 * ks + 8 * hq) * 2); acc = MFMA32(af, qf[ks], acc); }
        unsigned cur[16];
#pragma unroll
        for (int i = 0; i < 16; ++i) { const unsigned kidx = (unsigned)(32 * kt + (i & 3) + 8 * (i >> 2) + 4 * hq); cur[i] = (f2ord(acc[i]) & ~127u) | kidx; }
        sort16_desc(cur);
        if (kt == 0) {
#pragma unroll
            for (int i = 0; i < 16; ++i) top[i] = cur[i];
        } else merge_top16(top, cur);
    }
    xmerge_top16(top);
}
__device__ __forceinline__ void topk_phase(const Args& a, LAS unsigned char* lds, int l, int tid, int lane, int wave, int jb, int je, int js, bool setup, LAS unsigned short* ids_lds = nullptr, int tok_base = 0) {
    const bf16* QP = (const bf16*)(a.ws + WS_QP); const bf16* SKB = (const bf16*)(a.ws + WS_SKB) + (size_t)l * 2 * 128 * 128; int* IDS = (int*)(a.ws + WS_IDS); float* GATE = (float*)(a.ws + WS_GATE);
    if (setup) {
    for (int i = tid; i < 2 * 128 * 16; i += NTHR) { const int row = i >> 4, ch = i & 15; *(LAS v4u*)(lds + (row >> 7) * TK_HALF + (row & 127) * TK_SKSTR + ch * 16) = *(const v4u*)(SKB + (size_t)row * 128 + ch * 8); }
    if (tid < 64) { int cnt = 0, ij = 0;
        for (int i = 0; i < 16; ++i) for (int j = 0; j < 16; ++j) if ((i + 1) * (j + 1) <= 16) { ij = (cnt == tid) ? (i * 16 + j) : ij; ++cnt; }
        ((LAS unsigned char*)(lds + TK_IJ))[tid] = (unsigned char)ij; }
    __syncthreads();
    }
    const int r = lane & 31, hq = lane >> 5;
    LAS unsigned char* scr = lds + TK_SCR + wave * 1024 + r * 32;
    for (int job = jb; job < je; job += js) {
        const int tt = job >> 3, hd = job & 7; const int tok = tt * 32 + r;
        const bf16* qrow = QP + (size_t)tok * D + hd * 256;
        unsigned t1[16], t2[16];
        topk_half(lds, qrow, lane, t1);
        __builtin_amdgcn_sched_barrier(0);
        topk_half(lds + TK_HALF, qrow + 128, lane, t2);
        __builtin_amdgcn_sched_barrier(0);
        float v1[16], v2[16];
#pragma unroll
        for (int i = 0; i < 16; ++i) { v1[i] = ord2f(t1[i] & ~127u); v2[i] = ord2f(t2[i] & ~127u); }
        unsigned ca[32], cb[32];
#pragma unroll
        for (int i = 0; i < 32; ++i) { ca[i] = 0u; cb[i] = 0u; }
        {
            int c = 0;
#pragma unroll
            for (int i = 0; i < 16; ++i)
#pragma unroll
                for (int j = 0; j < 16; ++j)
                    if ((i + 1) * (j + 1) <= 16) { const unsigned key = (f2ord(v1[i] + v2[j]) & ~63u) | (unsigned)c; if (c < 32) ca[c] = key; else cb[c - 32] = key; ++c; }
        }
        unsigned m0[16], m1[16]; const unsigned smhi = hq ? 0xffffffffu : 0u, smlo = ~smhi;
#pragma unroll
        for (int i = 0; i < 16; ++i) { m0[i] = (ca[i] & smlo) | (cb[i] & smhi); m1[i] = (ca[16 + i] & smlo) | (cb[16 + i] & smhi); }
        sort16_desc(m0); sort16_desc(m1); merge_top16(m0, m1); xmerge_top16(m0);
        float sv[16]; float se = 0.f;
#pragma unroll
        for (int i = 0; i < 16; ++i) { sv[i] = __expf(ord2f(m0[i] & ~63u) - ord2f(m0[0] & ~63u)); se += sv[i]; }
        const float inv = 1.0f / se;
        if (hq == 0) {
#pragma unroll
            for (int q = 0; q < 4; ++q) { ((LAS unsigned*)scr)[q] = (t1[4 * q] & 127u) | ((t1[4 * q + 1] & 127u) << 8) | ((t1[4 * q + 2] & 127u) << 16) | ((t1[4 * q + 3] & 127u) << 24);
                ((LAS unsigned*)scr)[4 + q] = (t2[4 * q] & 127u) | ((t2[4 * q + 1] & 127u) << 8) | ((t2[4 * q + 2] & 127u) << 16) | ((t2[4 * q + 3] & 127u) << 24); }
        }
        asm volatile("s_waitcnt lgkmcnt(0)" ::: "memory");
        v2u outv[8]; const unsigned mhi = hq ? 0xffffffffu : 0u, mlo = ~mhi;
#pragma unroll
        for (int k = 0; k < 8; ++k) { const unsigned key = (m0[k] & mlo) | (m0[8 + k] & mhi); const float gt = __uint_as_float((__float_as_uint(sv[k]) & mlo) | (__float_as_uint(sv[8 + k]) & mhi)) * inv;
            const unsigned ij = ((const LAS unsigned char*)(lds + TK_IJ))[key & 63u]; const unsigned e1 = scr[ij >> 4], e2 = scr[16 + (ij & 15u)];
            outv[k].x = e1 * 128u + e2; outv[k].y = __float_as_uint(gt); }
        const size_t so = (size_t)tok * 128 + hd * 16 + 8 * hq;
        *(v4u*)(IDS + so) = (v4u){outv[0].x, outv[1].x, outv[2].x, outv[3].x}; *(v4u*)(IDS + so + 4) = (v4u){outv[4].x, outv[5].x, outv[6].x, outv[7].x};
        { const v4u pk_ = (v4u){outv[0].x | (outv[1].x << 16), outv[2].x | (outv[3].x << 16), outv[4].x | (outv[5].x << 16), outv[6].x | (outv[7].x << 16)};
          if (ids_lds) *(LAS v4u*)(ids_lds + (size_t)(tok - tok_base) * 128 + hd * 16 + 8 * hq) = pk_; else *(v4u*)((unsigned short*)(a.ws + WS_IDS16) + so) = pk_; }
        *(v4u*)(GATE + so) = (v4u){outv[0].y, outv[1].y, outv[2].y, outv[3].y}; *(v4u*)(GATE + so + 4) = (v4u){outv[4].y, outv[5].y, outv[6].y, outv[7].y};
        asm volatile("s_waitcnt lgkmcnt(0)" ::: "memory");
    }
}

#ifndef GATHER_REP
#define GATHER_REP 1
#endif
__device__ __forceinline__ void gather_phase(const Args& a, int l, int lane, int wave) {
    const bf16* H = (const bf16*)(a.ws + WS_H); const int* IDS = (const int*)(a.ws + WS_IDS); const float* GATE = (const float*)(a.ws + WS_GATE);
    const unsigned char* PU = a.ws + WS_PU + (size_t)l * NE * D; const unsigned char* PV = a.ws + WS_PV + (size_t)l * NE * D;
    const float* DSU = (const float*)(a.ws + WS_DS) + (size_t)l * NE; const float* DSV = (const float*)(a.ws + WS_DS) + (size_t)(DEPTH + l) * NE;
    const float* modv = (const float*)(a.ws + WS_MOD);
    const int gw = blockIdx.x * NWAVES + wave, NGW = gridDim.x * NWAVES;
    for (int t = gw; t < M; t += NGW) {
        const int b = t / SEQ;
        float hv[32];
#pragma unroll
        for (int i = 0; i < 2; ++i)
#pragma unroll
            for (int hf = 0; hf < 2; ++hf) { const v4u w = *(const v4u*)(H + (size_t)t * D + 1024 * i + 16 * lane + 8 * hf);
#pragma unroll
                for (int k = 0; k < 4; ++k) { hv[16 * i + 8 * hf + 2 * k] = bf_lo(w[k]); hv[16 * i + 8 * hf + 2 * k + 1] = bf_hi(w[k]); } }
        v2u s0, s1; s0.x = (unsigned)IDS[(size_t)t * 128 + lane]; s1.x = (unsigned)IDS[(size_t)t * 128 + 64 + lane]; s0.y = __float_as_uint(GATE[(size_t)t * 128 + lane]); s1.y = __float_as_uint(GATE[(size_t)t * 128 + 64 + lane]);
        const float du0 = DSU[s0.x], du1 = DSU[s1.x], dv0 = DSV[s0.x], dv1 = DSV[s1.x];
        float out[32];
#pragma unroll
        for (int i = 0; i < 32; ++i) out[i] = 0.f;
#pragma unroll 1
        for (int grep_ = 0; grep_ < GATHER_REP; ++grep_) {
        asm volatile("" ::: "memory");
        float dsel0 = 0.f, dsel1 = 0.f;
#pragma unroll 1
        for (int grp = 0; grp < 16; ++grp) {
            const unsigned eme = (grp & 8) ? s1.x : s0.x; const int lb = (grp & 7) * 8;
            v4u uv[8][2];
#pragma unroll
            for (int q = 0; q < 8; ++q) { const unsigned e = (unsigned)__builtin_amdgcn_readlane((int)eme, lb + q); const unsigned char* urow = PU + (size_t)e * D + 16 * lane;
#pragma unroll
                for (int i = 0; i < 2; ++i) uv[q][i] = *(const v4u*)(urow + 1024 * i); }
            float part[8];
#pragma unroll
            for (int q = 0; q < 8; ++q) { float s = 0.f, s2 = 0.f;
#pragma unroll
                for (int i = 0; i < 2; ++i)
#pragma unroll
                    for (int k = 0; k < 4; ++k) { const f32x2 lo = __builtin_amdgcn_cvt_pk_f32_fp8((int)uv[q][i][k], false), hi = __builtin_amdgcn_cvt_pk_f32_fp8((int)uv[q][i][k], true);
                        s += lo.x * hv[16 * i + 4 * k]; s2 += lo.y * hv[16 * i + 4 * k + 1]; s += hi.x * hv[16 * i + 4 * k + 2]; s2 += hi.y * hv[16 * i + 4 * k + 3]; }
                part[q] = s + s2; }
#pragma unroll
            for (int o = 4; o >= 1; o >>= 1) {
                const bool up = (lane & o) != 0;
#pragma unroll
                for (int i = 0; i < o; ++i) { const float lo = part[i], hi = part[i + o]; const float send = up ? lo : hi, keep = up ? hi : lo; part[i] = keep + __shfl_xor(send, o); }
            }
            float tot = part[0]; tot += __shfl_xor(tot, 8); tot += __shfl_xor(tot, 16); tot += __shfl_xor(tot, 32);
            const bool mine = (lane >> 3) == (grp & 7);
            if (grp & 8) dsel1 = mine ? tot : dsel1; else dsel0 = mine ? tot : dsel0;
        }
        const float w0 = __uint_as_float(s0.y) * gelu1(dsel0 * du0) * dv0, w1 = __uint_as_float(s1.y) * gelu1(dsel1 * du1) * dv1;
#pragma unroll 1
        for (int grp = 0; grp < 16; ++grp) {
            const unsigned eme = (grp & 8) ? s1.x : s0.x; const unsigned wme = __float_as_uint((grp & 8) ? w1 : w0); const int lb = (grp & 7) * 8;
            v4u vv[8][2];
#pragma unroll
            for (int q = 0; q < 8; ++q) { const unsigned e = (unsigned)__builtin_amdgcn_readlane((int)eme, lb + q); const unsigned char* vrow = PV + (size_t)e * D + 16 * lane;
#pragma unroll
                for (int i = 0; i < 2; ++i) vv[q][i] = *(const v4u*)(vrow + 1024 * i); }
#pragma unroll
            for (int q = 0; q < 8; ++q) { const float w = __uint_as_float((unsigned)__builtin_amdgcn_readlane((int)wme, lb + q));
#pragma unroll
                for (int i = 0; i < 2; ++i)
#pragma unroll
                    for (int k = 0; k < 4; ++k) { const f32x2 lo = __builtin_amdgcn_cvt_pk_f32_fp8((int)vv[q][i][k], false), hi = __builtin_amdgcn_cvt_pk_f32_fp8((int)vv[q][i][k], true);
                        out[16 * i + 4 * k] += w * lo.x; out[16 * i + 4 * k + 1] += w * lo.y; out[16 * i + 4 * k + 2] += w * hi.x; out[16 * i + 4 * k + 3] += w * hi.y; }
                }
        }
        }
        if (GATHER_REP > 1) {
#pragma unroll
            for (int i = 0; i < 32; ++i) out[i] *= (1.0f / GATHER_REP); }
        int ln = lane; asm volatile("" : "+v"(ln));
        const float* xr = a.out + (size_t)t * D; const float* gf = modv + (size_t)(l * NB + b) * NMOD + 5 * D;
        float ssq = 0.f;
#pragma unroll
        for (int i = 0; i < 2; ++i)
#pragma unroll
            for (int q = 0; q < 4; ++q) { const int c = 1024 * i + 16 * ln + 4 * q; const f32x4 xv = *(const f32x4*)(xr + c), gv = *(const f32x4*)(gf + c);
#pragma unroll
                for (int k = 0; k < 4; ++k) { const float nv = xv[k] + gv[k] * out[16 * i + 4 * q + k]; out[16 * i + 4 * q + k] = nv; ssq += nv * nv; }
                if (q == 3) asm volatile("" ::: "memory"); }
        const float rstd = 1.0f / sqrtf(wave_sum(ssq) * (1.0f / D) + EPS);
        if (l + 1 < DEPTH) {
            const float* gain = a.in[4] + (size_t)(l + 1) * D; const float* mb = modv + (size_t)((l + 1) * NB + b) * NMOD;
            float* xw = a.out + (size_t)t * D; bf16* hw = (bf16*)(a.ws + WS_H) + (size_t)t * D;
#pragma unroll
            for (int i = 0; i < 2; ++i) { unsigned pk[8];
#pragma unroll
                for (int q = 0; q < 4; ++q) { const int c = 1024 * i + 16 * ln + 4 * q; const f32x4 gn = *(const f32x4*)(gain + c), scv = *(const f32x4*)(mb + D + c), shv = *(const f32x4*)(mb + c);
                    f32x4 nv = (f32x4){out[16 * i + 4 * q], out[16 * i + 4 * q + 1], out[16 * i + 4 * q + 2], out[16 * i + 4 * q + 3]};
                    *(f32x4*)(xw + c) = nv; const f32x4 o = nv * rstd * gn * (scv + 1.0f) + shv; pk[2 * q] = cvt_pk_bf16(o[0], o[1]); pk[2 * q + 1] = cvt_pk_bf16(o[2], o[3]);
                    if (q & 1) asm volatile("" ::: "memory"); }
                *(v4u*)(hw + 1024 * i + 16 * ln) = (v4u){pk[0], pk[1], pk[2], pk[3]}; *(v4u*)(hw + 1024 * i + 16 * ln + 8) = (v4u){pk[4], pk[5], pk[6], pk[7]}; }
        } else {
            const float* gain = a.in[23]; float* xw = a.out + (size_t)t * D;
#pragma unroll
            for (int i = 0; i < 2; ++i)
#pragma unroll
                for (int q = 0; q < 4; ++q) { const int c = 1024 * i + 16 * ln + 4 * q; const f32x4 gn = *(const f32x4*)(gain + c);
                    const f32x4 nv = (f32x4){out[16 * i + 4 * q], out[16 * i + 4 * q + 1], out[16 * i + 4 * q + 2], out[16 * i + 4 * q + 3]}; *(f32x4*)(xw + c) = nv * rstd * gn; }
        }
    }
}

__device__ __forceinline__ bool peer_item(const PeerMap& pm, int k, int& s, int& tb) {
    if (pm.fast) { if (k >= 8) return false; s = 2 * pm.x + (k >> 2); tb = pm.r + 32 * (k & 3); return true; }
    const int it = blockIdx.x + k * gridDim.x; if (it >= 2048) return false; s = it >> 7; tb = it & 127; return true;
}
#define PU_IDS(ID, t_) do { const v4u* idp_ = (const v4u*)(IDS16 + (size_t)(t_) * 128 + 16 * rg); ID[0] = idp_[0]; ID[1] = idp_[1]; } while (0)
#define PU_ROWS(RV, ID, base_) do { _Pragma("unroll") for (int j_ = 0; j_ < 16; ++j_) { const unsigned w_ = ID[j_ >> 3][(j_ >> 1) & 3]; const unsigned e_ = (j_ & 1) ? (w_ >> 16) : (w_ & 0xffffu); \
        RV[j_] = *(const v4u*)((base_) + (e_ * 128u + co)); } } while (0)
#define PU_H(HR, t_) do { HR = *(const v4u*)(HQ + (size_t)(t_) * D + s * 128 + co); } while (0)
#define PU_COMPUTE(RV, HR, t_) do { int part[16]; \
        _Pragma("unroll") for (int j = 0; j < 16; ++j) { int s_ = __builtin_amdgcn_sdot4((int)RV[j].x, (int)HR.x, 0, false); s_ = __builtin_amdgcn_sdot4((int)RV[j].y, (int)HR.y, s_, false); \
            s_ = __builtin_amdgcn_sdot4((int)RV[j].z, (int)HR.z, s_, false); part[j] = __builtin_amdgcn_sdot4((int)RV[j].w, (int)HR.w, s_, false); } \
        _Pragma("unroll") for (int o = 4, n = 8; o >= 1; o >>= 1, n >>= 1) { const bool up = (ln & o) != 0; \
            _Pragma("unroll") for (int q = 0; q < n; ++q) { const int lo = part[q], hi = part[q + n]; const int send = up ? lo : hi, keep = up ? hi : lo; part[q] = keep + __shfl_xor(send, o); } } \
        P[((size_t)s * M + (t_)) * 64 + 8 * rg + c8] = cvt_pk_bf16((float)part[0], (float)part[1]); } while (0)
__device__ __forceinline__ void peer_u_phase(const Args& a, int l, const PeerMap& pm, int lane, int wave) {
    const unsigned char* HQ = a.ws + WS_HQ; const unsigned short* IDS16 = (const unsigned short*)(a.ws + WS_IDS16); unsigned* P = (unsigned*)(a.ws + WS_P);
    const unsigned char* PU = a.ws + WS_PU + (size_t)l * NE * D;
    int s, tb;
#pragma unroll 1
    for (int k_ = 0; peer_item(pm, k_, s, tb); ++k_) {
        int ln = lane; asm volatile("" : "+v"(ln)); const int c8 = ln & 7, rg = ln >> 3; const unsigned co = 16u * (unsigned)c8;
        const unsigned char* ub = PU + (size_t)s * NE * 128; const int t0 = tb * 128 + wave * 16;
        v4u id[2], rvA[16], rvB[16], hA, hB;
        PU_IDS(id, t0); PU_H(hA, t0); PU_ROWS(rvA, id, ub); PU_IDS(id, t0 + 1); PU_H(hB, t0 + 1);
#pragma unroll 1
        for (int i = 0; i < 16; i += 2) {
            const int t2 = t0 + (i + 2 < 16 ? i + 2 : 15), t3 = t0 + (i + 3 < 16 ? i + 3 : 15);
            PU_ROWS(rvB, id, ub); PU_IDS(id, t2);
            PU_COMPUTE(rvA, hA, t0 + i);
            PU_H(hA, t2); PU_ROWS(rvA, id, ub); PU_IDS(id, t3);
            PU_COMPUTE(rvB, hB, t0 + i + 1);
            PU_H(hB, t3);
        }
    }
}
__device__ __forceinline__ void peer_act_phase(const Args& a, int l, int lane, int wave) {
    const unsigned* P = (const unsigned*)(a.ws + WS_P); const int* IDS = (const int*)(a.ws + WS_IDS); const float* GATE = (const float*)(a.ws + WS_GATE);
    const float* DSU = (const float*)(a.ws + WS_DS) + (size_t)l * NE; const float* DSV = (const float*)(a.ws + WS_DS) + (size_t)(DEPTH + l) * NE; const float* HQS = (const float*)(a.ws + WS_HQS);
    unsigned* WQ8 = (unsigned*)(a.ws + WS_WQ8); float* WS = (float*)(a.ws + WS_WS);
    const int gw = blockIdx.x * NWAVES + wave, NGW = gridDim.x * NWAVES;
    for (int tp = gw; tp < M / 2; tp += NGW) {
        const int t = 2 * tp + (lane >> 5); const size_t i = (size_t)t * 128 + 4 * (lane & 31);
        v2u sv[16];
#pragma unroll
        for (int sl = 0; sl < 16; ++sl) sv[sl] = *(const v2u*)(P + ((size_t)sl * M * 128 + i) / 2);
        const v4u e = *(const v4u*)(IDS + i); const f32x4 g = *(const f32x4*)(GATE + i); const float hs = HQS[t];
        f32x4 s = (f32x4){0.f, 0.f, 0.f, 0.f};
#pragma unroll
        for (int sl = 0; sl < 16; ++sl) { s[0] += bf_lo(sv[sl].x); s[1] += bf_hi(sv[sl].x); s[2] += bf_lo(sv[sl].y); s[3] += bf_hi(sv[sl].y); }
        f32x4 w; float mx = 0.f;
#pragma unroll
        for (int k = 0; k < 4; ++k) { w[k] = g[k] * gelu1(s[k] * hs * DSU[e[k]]) * DSV[e[k]]; mx = fmaxf(mx, fabsf(w[k])); }
#pragma unroll
        for (int o = 1; o < 32; o <<= 1) mx = fmaxf(mx, __shfl_xor(mx, o));
        const float q = mx > 0.f ? 127.0f / mx : 1.0f;
        WQ8[i >> 2] = pack_i8(w[0] * q, w[1] * q, w[2] * q, w[3] * q);
        if ((lane & 31) == 0) WS[t] = mx > 0.f ? mx * (1.0f / 127.0f) : 1.0f;
    }
}
#define PV_W(WR, t_) do { WR = *(const v4u*)(WQ8 + (size_t)(t_) * 128 + 16 * rg); } while (0)
#define PV_COMPUTE(RV, WR, t_) do { int o16[16]; \
        _Pragma("unroll") for (int k = 0; k < 16; ++k) o16[k] = 0; \
        _Pragma("unroll") for (int g_ = 0; g_ < 4; ++g_) { const int wg_ = (int)WR[g_]; \
            _Pragma("unroll") for (int c_ = 0; c_ < 4; ++c_) { const unsigned ra = RV[4 * g_][c_], rb = RV[4 * g_ + 1][c_], rc = RV[4 * g_ + 2][c_], rd = RV[4 * g_ + 3][c_]; \
                const unsigned x0 = __builtin_amdgcn_perm(rb, ra, 0x05010400u), x1 = __builtin_amdgcn_perm(rb, ra, 0x07030602u), y0 = __builtin_amdgcn_perm(rd, rc, 0x05010400u), y1 = __builtin_amdgcn_perm(rd, rc, 0x07030602u); \
                o16[4 * c_ + 0] = __builtin_amdgcn_sdot4((int)__builtin_amdgcn_perm(y0, x0, 0x05040100u), wg_, o16[4 * c_ + 0], false); \
                o16[4 * c_ + 1] = __builtin_amdgcn_sdot4((int)__builtin_amdgcn_perm(y0, x0, 0x07060302u), wg_, o16[4 * c_ + 1], false); \
                o16[4 * c_ + 2] = __builtin_amdgcn_sdot4((int)__builtin_amdgcn_perm(y1, x1, 0x05040100u), wg_, o16[4 * c_ + 2], false); \
                o16[4 * c_ + 3] = __builtin_amdgcn_sdot4((int)__builtin_amdgcn_perm(y1, x1, 0x07060302u), wg_, o16[4 * c_ + 3], false); } } \
        _Pragma("unroll") for (int o = 32, n = 8; o >= 8; o >>= 1, n >>= 1) { const bool up = (ln & o) != 0; \
            _Pragma("unroll") for (int q = 0; q < n; ++q) { const int lo = o16[q], hi = o16[q + n]; const int send = up ? lo : hi, keep = up ? hi : lo; o16[q] = keep + __shfl_xor(send, o); } } \
        const int col = s * 128 + 16 * c8 + 2 * rg; const float ws_ = WS[(t_)]; \
        unsigned* xp = (unsigned*)(XB + (size_t)(t_) * D + col); const unsigned xv = *xp; const f32x2 gv = *(const f32x2*)(modv + (size_t)(l * NB + (t_) / SEQ) * NMOD + 5 * D + col); \
        *xp = cvt_pk_bf16(bf_lo(xv) + gv.x * (ws_ * (float)o16[0]), bf_hi(xv) + gv.y * (ws_ * (float)o16[1])); } while (0)
__device__ __forceinline__ void peer_v_phase(const Args& a, int l, const PeerMap& pm, int lane, int wave) {
    const unsigned short* IDS16 = (const unsigned short*)(a.ws + WS_IDS16); const unsigned char* WQ8 = a.ws + WS_WQ8; const float* WS = (const float*)(a.ws + WS_WS);
    const unsigned char* PV = a.ws + WS_PV + (size_t)l * NE * D; const float* modv = (const float*)(a.ws + WS_MOD); bf16* XB = (bf16*)(a.ws + WS_XB);
    int s, tb;
#pragma unroll 1
    for (int k_ = 0; peer_item(pm, k_, s, tb); ++k_) {
        int ln = lane; asm volatile("" : "+v"(ln)); const int c8 = ln & 7, rg = ln >> 3; const unsigned co = 16u * (unsigned)c8;
        const unsigned char* vb = PV + (size_t)s * NE * 128; const int t0 = tb * 128 + wave * 16;
        v4u id[2], rvA[16], rvB[16], wA, wB;
        PU_IDS(id, t0); PV_W(wA, t0); PU_ROWS(rvA, id, vb); PU_IDS(id, t0 + 1); PV_W(wB, t0 + 1);
#pragma unroll 1
        for (int i = 0; i < 16; i += 2) {
            const int t2 = t0 + (i + 2 < 16 ? i + 2 : 15), t3 = t0 + (i + 3 < 16 ? i + 3 : 15);
            PU_ROWS(rvB, id, vb); PU_IDS(id, t2);
            PV_COMPUTE(rvA, wA, t0 + i);
            PV_W(wA, t2); PU_ROWS(rvA, id, vb); PU_IDS(id, t3);
            PV_COMPUTE(rvB, wB, t0 + i + 1);
            PV_W(wB, t3);
        }
    }
}
__device__ __forceinline__ void peer_norm_phase(const Args& a, int l, int lane, int wave) {
    const int gw = blockIdx.x * NWAVES + wave, NGW = gridDim.x * NWAVES; const float* modv = (const float*)(a.ws + WS_MOD); const bf16* XB = (const bf16*)(a.ws + WS_XB);
    if (l + 1 < DEPTH) { for (int m = gw; m < M; m += NGW) { const float* mb = modv + (size_t)((l + 1) * NB + m / SEQ) * NMOD; modnorm_row<3, true>(XB + (size_t)m * D, a.in[4] + (size_t)(l + 1) * D, mb + D, mb, nullptr, lane, a.ws + WS_H8 + (size_t)m * D, (float*)(a.ws + WS_HS) + m); } }
    else { for (int m = gw; m < M; m += NGW) { const bf16* xrow = XB + (size_t)m * D; float* orow = a.out + (size_t)m * D; f32x4 v[8]; float s = 0.f;
#pragma unroll
            for (int j = 0; j < 8; ++j) { const v2u w = *(const v2u*)(xrow + 4 * lane + 256 * j); v[j] = (f32x4){bf_lo(w.x), bf_hi(w.x), bf_lo(w.y), bf_hi(w.y)}; s += (v[j][0] * v[j][0] + v[j][1] * v[j][1]) + (v[j][2] * v[j][2] + v[j][3] * v[j][3]); }
            const float rstd = 1.0f / sqrtf(wave_sum(s) * (1.0f / D) + EPS);
#pragma unroll
            for (int j = 0; j < 8; ++j) { const f32x4 gn = *(const f32x4*)(a.in[23] + 4 * lane + 256 * j); *(f32x4*)(orow + 4 * lane + 256 * j) = v[j] * rstd * gn; } } }
}

__device__ __forceinline__ void peer_fused_phase(const Args& a, LAS unsigned char* lds, int l, int, int wave) {
#define PF_WS() GAS unsigned char* wsg_ = (GAS unsigned char*)a.ws; asm volatile("" : "+s"(wsg_)); unsigned char* ws_ = (unsigned char*)wsg_
#if !PEER_VMFMA
    { int tid2 = threadIdx.x; asm volatile("" : "+v"(tid2)); topk_phase(a, lds, l, tid2, tid2 & 63, wave, 0, 0, 1, true); }
#endif
    for (int tb = blockIdx.x; tb < M / 64; tb += gridDim.x) {
#if PEER_VMFMA
        __syncthreads();
        { int tid2 = threadIdx.x; asm volatile("" : "+v"(tid2)); topk_phase(a, lds, l, tid2, tid2 & 63, wave, 0, 0, 1, true); }
#endif
#if PEER_VMFMA
        LAS unsigned short* ids_l = (LAS unsigned short*)(lds + 8 * 16640);
        { int tid2 = threadIdx.x; asm volatile("" : "+v"(tid2)); topk_phase(a, lds, l, tid2, tid2 & 63, wave, tb * 16 + wave, tb * 16 + 16, 8, false, ids_l, tb * 64); }
#define PF_IDS(ID, t_) do { const LAS v4u* idp_ = (const LAS v4u*)(ids_l + ((t_) - tb * 64) * 128 + 16 * rg); ID[0] = idp_[0]; ID[1] = idp_[1]; } while (0)
#else
        { int tid2 = threadIdx.x; asm volatile("" : "+v"(tid2)); topk_phase(a, lds, l, tid2, tid2 & 63, wave, tb * 16 + wave, tb * 16 + 16, 8, false); }
#define PF_IDS(ID, t_) PU_IDS(ID, t_)
#endif
        __builtin_amdgcn_fence(__ATOMIC_RELEASE, "workgroup"); __syncthreads(); __builtin_amdgcn_fence(__ATOMIC_ACQUIRE, "workgroup");
        int ln = threadIdx.x & 63; asm volatile("" : "+v"(ln)); const int c8 = ln & 7, rg = ln >> 3; const unsigned co = 16u * (unsigned)c8;
#if PEER_VMFMA
        LAS unsigned char* wq_l = lds + 8 * 16640 + 16384 + wave * 1056;
        LAS unsigned char* vbuf = lds + wave * 16640;
        LAS unsigned char* accb = vbuf + ln * 8;
#else
        LAS unsigned char* accb = lds + 81920 + wave * 4096 + ln * 8;
#endif
        const int t0 = tb * 64 + wave * 8;
#define PF_XCH(v_, o_) ((o_) == 4 ? __builtin_amdgcn_update_dpp(0, (v_), 0x141, 0xf, 0xf, false) : (o_) == 2 ? __builtin_amdgcn_update_dpp(0, (v_), 0x4e, 0xf, 0xf, false) : __builtin_amdgcn_update_dpp(0, (v_), 0xb1, 0xf, 0xf, false))
#define PF_UCOMPUTE(RV, HR, i_) do { int part[16]; \
        _Pragma("unroll") for (int j = 0; j < 16; ++j) { int s_ = __builtin_amdgcn_sdot4((int)RV[j].x, (int)HR.x, 0, false); s_ = __builtin_amdgcn_sdot4((int)RV[j].y, (int)HR.y, s_, false); \
            s_ = __builtin_amdgcn_sdot4((int)RV[j].z, (int)HR.z, s_, false); part[j] = __builtin_amdgcn_sdot4((int)RV[j].w, (int)HR.w, s_, false); } \
        _Pragma("unroll") for (int o = 4, n = 8; o >= 1; o >>= 1, n >>= 1) { const bool up = (ln & o) != 0; \
            _Pragma("unroll") for (int q = 0; q < n; ++q) { const int lo = part[q], hi = part[q + n]; const int send = up ? lo : hi, keep = up ? hi : lo; part[q] = keep + PF_XCH(send, o); } } \
        LAS v2u* ap_ = (LAS v2u*)(accb + (i_) * 512); v2u av_ = s ? *ap_ : (v2u){0u, 0u}; av_.x += (unsigned)part[0]; av_.y += (unsigned)part[1]; *ap_ = av_; } while (0)
        { PF_WS(); const unsigned char* HQ = ws_ + WS_HQ; const unsigned short* IDS16 = (const unsigned short*)(ws_ + WS_IDS16); const unsigned char* PU = ws_ + WS_PU + (size_t)l * NE * D;
#if PEER_VMFMA
        LAS unsigned char* hbuf = vbuf + 4096;
#define PF_HT_LOAD(REG, s_) do { REG = __builtin_nontemporal_load((const v4u*)(HQ + (size_t)(t0 + rg) * D + (s_) * 128 + co)); } while (0)
#define PF_HT_PUT(REG, s_) do { *(LAS v4u*)(hbuf + ((s_) & 1) * 1024 + rg * 128 + co) = REG; } while (0)
#define PF_H(HR, q_) do { HR = *(const LAS v4u*)(hbuf + (((q_) >> 3) & 1) * 1024 + ((q_) & 7) * 128 + co); } while (0)
#else
#define PF_H(HR, q_) do { HR = __builtin_nontemporal_load((const v4u*)(HQ + (size_t)(t0 + ((q_) & 7)) * D + ((q_) >> 3) * 128 + co)); } while (0)
#endif
#define PF_UB(q_) (PU + (size_t)((q_) >> 3) * NE * 128)
        {
            {
            const bool defer = PEER_DEFER && (l + 1 < DEPTH) && (tb == (int)blockIdx.x); const int qs1 = defer ? 8 * wave : 0, qs2 = defer ? 64 + 8 * wave : 0;
#pragma unroll 1
            for (int seg = 0; seg < 3; ++seg) {
            const int qa = seg == 0 ? 0 : seg == 1 ? qs1 : qs2, qb = seg == 0 ? qs1 : seg == 1 ? qs2 : 128;
            if (qa < qb) {
            v4u idA[2], idB[2], rvA[16], rvB[16], hA, hB;
#if PEER_VMFMA
            v4u ht; { const int sa_ = qa >> 3; PF_HT_LOAD(ht, sa_); PF_HT_PUT(ht, sa_); PF_HT_LOAD(ht, sa_ + 1 < 16 ? sa_ + 1 : 15); }
#endif
            PF_IDS(idA, t0 + (qa & 7)); PF_IDS(idB, t0 + ((qa + 1) & 7)); PF_H(hA, qa); PF_H(hB, qa + 1); PU_ROWS(rvA, idA, PF_UB(qa)); PF_IDS(idA, t0 + ((qa + 2 < qb ? qa + 2 : qb - 1) & 7));
#pragma unroll 1
            for (int q = qa; q < qb; q += 2) {
                const int q2 = q + 2 < qb ? q + 2 : qb - 1, q3 = q + 3 < qb ? q + 3 : qb - 1, q4 = q + 4 < qb ? q + 4 : qb - 1;
#if PEER_VMFMA
                if ((q & 7) == 4) { const int s1_ = (q >> 3) + 1 < 16 ? (q >> 3) + 1 : 15, s2_ = (q >> 3) + 2 < 16 ? (q >> 3) + 2 : 15; PF_HT_PUT(ht, s1_); PF_HT_LOAD(ht, s2_); }
#endif
                PU_ROWS(rvB, idB, PF_UB(q + 1)); PF_IDS(idB, t0 + (q3 & 7));
                { const int s = q >> 3; PF_UCOMPUTE(rvA, hA, q & 7); }
                PF_H(hA, q2); PU_ROWS(rvA, idA, PF_UB(q2)); PF_IDS(idA, t0 + (q4 & 7));
                { const int s = (q + 1) >> 3; PF_UCOMPUTE(rvB, hB, (q + 1) & 7); }
                PF_H(hB, q3);
            }
            }
            if (seg < 2 && defer) {
                Args a2 = a; a2.ws = ws_;
                const int gw = blockIdx.x * NWAVES + wave, NGW = gridDim.x * NWAVES;
                for (int c = gw; c < 2 * NE / 16; c += NGW)
#pragma unroll 1
                    for (int i = 8 * seg; i < 8 * seg + 8; i += 2) { const int rr = c * 16 + i, tab = rr >= NE; peer_conv_row2(a2, tab, (l + 1) * NE + rr - tab * NE, ln); }
            }
            }
            }
        }
#undef PF_H
#undef PF_HT_LOAD
#undef PF_HT_PUT
#undef PF_UB
        }
        { PF_WS(); const int* IDS = (const int*)(ws_ + WS_IDS); const float* GATE = (const float*)(ws_ + WS_GATE); const float* DSU = (const float*)(ws_ + WS_DS) + (size_t)l * NE; const float* DSV = (const float*)(ws_ + WS_DS) + (size_t)(DEPTH + l) * NE;
          const float* HQS = (const float*)(ws_ + WS_HQS); unsigned char* WQ8 = ws_ + WS_WQ8; float* WS = (float*)(ws_ + WS_WS);
          { v2u av[8], e[8]; f32x2 g[8]; float hs[8], du0[8], du1[8], dv0[8], dv1[8];
            const size_t kb0 = (size_t)t0 * 128 + 16 * rg + 2 * c8;
#pragma unroll
            for (int i = 0; i < 8; ++i) { av[i] = *(const LAS v2u*)(accb + i * 512); e[i] = *(const v2u*)(IDS + kb0 + 128 * i); g[i] = *(const f32x2*)(GATE + kb0 + 128 * i); hs[i] = HQS[t0 + i]; }
#pragma unroll
            for (int i = 0; i < 8; ++i) { du0[i] = DSU[e[i].x]; du1[i] = DSU[e[i].y]; dv0[i] = DSV[e[i].x]; dv1[i] = DSV[e[i].y]; }
#pragma unroll
            for (int i = 0; i < 8; ++i) {
                const float w0 = g[i].x * gelu1((float)(int)av[i].x * hs[i] * du0[i]) * dv0[i], w1 = g[i].y * gelu1((float)(int)av[i].y * hs[i] * du1[i]) * dv1[i];
                float mx = fmaxf(fabsf(w0), fabsf(w1));
#pragma unroll
                for (int o = 1; o < 64; o <<= 1) mx = fmaxf(mx, __shfl_xor(mx, o));
                const float q = mx > 0.f ? 127.0f / mx : 1.0f;
                const int i0 = (int)rintf(w0 * q), i1 = (int)rintf(w1 * q);
#if PEER_VMFMA
                *(LAS unsigned short*)(wq_l + i * 128 + 16 * rg + 2 * c8) = (unsigned short)(((unsigned)i0 & 255u) | (((unsigned)i1 & 255u) << 8));
                if (ln == 0) *(LAS float*)(wq_l + 1024 + 4 * i) = mx > 0.f ? mx * (1.0f / 127.0f) : 1.0f; }
#else
                *(unsigned short*)(WQ8 + kb0 + 128 * i) = (unsigned short)(((unsigned)i0 & 255u) | (((unsigned)i1 & 255u) << 8));
                if (ln == 0) WS[t0 + i] = mx > 0.f ? mx * (1.0f / 127.0f) : 1.0f; }
#endif
          }
        }
        __builtin_amdgcn_fence(__ATOMIC_RELEASE, "workgroup"); asm volatile("s_waitcnt vmcnt(0)" ::: "memory"); __builtin_amdgcn_fence(__ATOMIC_ACQUIRE, "workgroup");
        { PF_WS(); const unsigned short* IDS16 = (const unsigned short*)(ws_ + WS_IDS16); const unsigned char* PV = ws_ + WS_PV + (size_t)l * NE * D; const unsigned char* WQ8 = ws_ + WS_WQ8; const float* WS = (const float*)(ws_ + WS_WS);
          const float* modv = (const float*)(ws_ + WS_MOD); bf16* XB = (bf16*)(ws_ + WS_XB);
#define PF_VB(q_) (PV + (size_t)((q_) >> 3) * NE * 128)
        {
#if PEER_VMFMA
            typedef int v4i_ __attribute__((ext_vector_type(4))); typedef int v2i_ __attribute__((ext_vector_type(2)));
            const int g4 = ln >> 4, i16 = ln & 15;
            LAS unsigned char* vwr = vbuf + ln * 16; LAS unsigned char* vrd = vbuf + (i16 >> 1) * 1040 + g4 * 128 + 8 * (i16 & 1);
#define PV2_W(WR, XV, GV, SF, t_, s_) do { const LAS unsigned char* wp_ = wq_l + ((t_) - t0) * 128 + 16 * g4; WR[0] = *(const LAS v4u*)wp_; WR[1] = *(const LAS v4u*)(wp_ + 64);     \
        const int col_ = (s_) * 128 + ocol; XV = __builtin_nontemporal_load((const unsigned*)(XB + (size_t)(t_) * D + col_)); SF = *(const LAS float*)(wq_l + 1024 + 4 * ((t_) - t0)) * vscale_; } while (0)
#if XB_NT_ST
#define PV2_ST(v, p) __builtin_nontemporal_store((v), (p))
#else
#define PV2_ST(v, p) (*(p) = (v))
#endif
#define PV2_PUT(RV) do { asm volatile("" ::: "memory"); \
        _Pragma("unroll") for (int j_ = 0; j_ < 16; ++j_) *(LAS v4u*)(vwr + j_ * 1040) = RV[j_]; asm volatile("" ::: "memory"); } while (0)
#define PV2_MMA(WR, XV, GV, SF, t_, s_) do { \
        int o8[8]; \
        _Pragma("unroll") for (int nb_ = 0; nb_ < 8; ++nb_) { v4i_ acc_ = (v4i_){0, 0, 0, 0}; \
            _Pragma("unroll") for (int kh_ = 0; kh_ < 2; ++kh_) { \
                const v2i_ b0_ = __builtin_amdgcn_ds_read_tr8_b64_v2i32((LAS v2i_*)(vrd + kh_ * 512 + nb_ * 16)), b1_ = __builtin_amdgcn_ds_read_tr8_b64_v2i32((LAS v2i_*)(vrd + 8320 + kh_ * 512 + nb_ * 16)); \
                acc_ = __builtin_amdgcn_mfma_i32_16x16x64_i8((v4i_){(int)WR[kh_].x, (int)WR[kh_].y, (int)WR[kh_].z, (int)WR[kh_].w}, (v4i_){b0_.x, b0_.y, b1_.x, b1_.y}, acc_, 0, 0, 0); } \
            o8[nb_] = acc_[0]; } \
        asm volatile("" ::: "memory"); \
        const int p0_ = gb1 ? (gb0 ? o8[6] : o8[4]) : (gb0 ? o8[2] : o8[0]), p1_ = gb1 ? (gb0 ? o8[7] : o8[5]) : (gb0 ? o8[3] : o8[1]); \
        const int rcv_ = __builtin_amdgcn_update_dpp(0, odd ? p0_ : p1_, 0xb1, 0xf, 0xf, false); const int lo_ = odd ? rcv_ : p0_, hi_ = odd ? p1_ : rcv_; \
        PV2_ST(cvt_pk_bf16(bf_lo(XV) + GV.x * (SF * (float)lo_), bf_hi(XV) + GV.y * (SF * (float)hi_)), (unsigned*)(XB + (size_t)(t_) * D + (s_) * 128 + ocol)); } while (0)
            const bool gb0 = (g4 & 1) != 0, gb1 = (g4 & 2) != 0, odd = (i16 & 1) != 0; const int ocol = 32 * g4 + 16 * (i16 & 1) + (i16 & 14);
#ifdef PF_VREP
#pragma unroll 1
            for (int vrep_ = 0; vrep_ < PF_VREP; ++vrep_) { const float vscale_ = vrep_ == PF_VREP - 1 ? 1.0f : 0.0f;
            if (vrep_) { __builtin_amdgcn_fence(__ATOMIC_RELEASE, "workgroup"); asm volatile("s_waitcnt vmcnt(0)" ::: "memory"); __builtin_amdgcn_fence(__ATOMIC_ACQUIRE, "workgroup"); }
#else
            { const float vscale_ = 1.0f;
#endif
            v4u idA[2], idB[2], rvA[16], rvB[16], wA[2], wB[2]; unsigned xA, xB; float sA, sB;
            const float* gvp = modv + (size_t)(l * NB + t0 / SEQ) * NMOD + 5 * D + ocol;
            f32x2 gA = *(const f32x2*)gvp, gN = *(const f32x2*)(gvp + 128);
#define gB gA
            PF_IDS(idA, t0); PF_IDS(idB, t0 + 1); PV2_W(wA, xA, gA, sA, t0, 0); PV2_W(wB, xB, gB, sB, t0 + 1, 0);
            PU_ROWS(rvA, idA, PF_VB(0)); PU_ROWS(rvB, idB, PF_VB(1)); PF_IDS(idA, t0 + 2); PF_IDS(idB, t0 + 3);
#pragma unroll 1
            for (int q = 0; q < 128; q += 2) {
                const int q2 = q + 2 < 128 ? q + 2 : 127, q3 = q + 3 < 128 ? q + 3 : 127, q4 = q + 4 < 128 ? q + 4 : 127, q5 = q + 5 < 128 ? q + 5 : 127;
                if ((q & 7) == 0 && q) { gA = gN; const int sn_ = (q >> 3) + 1 < 16 ? (q >> 3) + 1 : 15; gN = *(const f32x2*)(gvp + 128 * sn_); }
                PV2_PUT(rvA); PU_ROWS(rvA, idA, PF_VB(q2)); PF_IDS(idA, t0 + (q4 & 7));
                PV2_MMA(wA, xA, gA, sA, t0 + (q & 7), q >> 3);
                PV2_W(wA, xA, gA, sA, t0 + (q2 & 7), q2 >> 3);
                PV2_PUT(rvB); PU_ROWS(rvB, idB, PF_VB(q3)); PF_IDS(idB, t0 + (q5 & 7));
                PV2_MMA(wB, xB, gB, sB, t0 + ((q + 1) & 7), (q + 1) >> 3);
                PV2_W(wB, xB, gB, sB, t0 + (q3 & 7), q3 >> 3);
            }
            }
#undef gB
#undef PV2_PUT
#undef PV2_MMA
#undef PV2_W
#else
            v4u id[2], rvA[16], rvB[16], wA, wB;
            PF_IDS(id, t0); PV_W(wA, t0); PU_ROWS(rvA, id, PF_VB(0)); PF_IDS(id, t0 + 1); PV_W(wB, t0 + 1);
#pragma unroll 1
            for (int q = 0; q < 128; q += 2) {
                const int q2 = q + 2 < 128 ? q + 2 : 127, q3 = q + 3 < 128 ? q + 3 : 127;
                PU_ROWS(rvB, id, PF_VB(q + 1)); PF_IDS(id, t0 + (q2 & 7));
                { const int s = q >> 3; PV_COMPUTE(rvA, wA, t0 + (q & 7)); }
                PV_W(wA, t0 + (q2 & 7)); PU_ROWS(rvA, id, PF_VB(q2)); PF_IDS(id, t0 + (q3 & 7));
                { const int s = (q + 1) >> 3; PV_COMPUTE(rvB, wB, t0 + ((q + 1) & 7)); }
                PV_W(wB, t0 + (q3 & 7));
            }
#endif
        }
#undef PF_VB
        }
        __builtin_amdgcn_fence(__ATOMIC_RELEASE, "workgroup"); asm volatile("s_waitcnt vmcnt(0)" ::: "memory"); __builtin_amdgcn_fence(__ATOMIC_ACQUIRE, "workgroup");
        { PF_WS(); const float* modv = (const float*)(ws_ + WS_MOD); const bf16* XB = (const bf16*)(ws_ + WS_XB);
        { int lane = threadIdx.x & 63; asm volatile("" : "+v"(lane));
          v2u xr[8], xn[8];
#pragma unroll
          for (int j = 0; j < 8; ++j) xr[j] = *(const v2u*)(XB + (size_t)t0 * D + 4 * lane + 256 * j);
          f32x4 gs[8], shv[8];
          if (l + 1 < DEPTH) { const float* mb = modv + (size_t)((l + 1) * NB + t0 / SEQ) * NMOD; const float* gain = a.in[4] + (size_t)(l + 1) * D;
#pragma unroll
              for (int j = 0; j < 8; ++j) { const int c = 4 * lane + 256 * j; gs[j] = *(const f32x4*)(gain + c) * (*(const f32x4*)(mb + D + c) + 1.0f); shv[j] = *(const f32x4*)(mb + c); } }
          else {
#pragma unroll
              for (int j = 0; j < 8; ++j) { gs[j] = *(const f32x4*)(a.in[23] + 4 * lane + 256 * j); shv[j] = (f32x4){0.f, 0.f, 0.f, 0.f}; } }
#pragma unroll 1
          for (int i = 0; i < 8; ++i) {
            const int m = t0 + i, mn = t0 + (i + 1 < 8 ? i + 1 : 7);
#pragma unroll
            for (int j = 0; j < 8; ++j) xn[j] = *(const v2u*)(XB + (size_t)mn * D + 4 * lane + 256 * j);
            if (l + 1 < DEPTH) modnorm_pre(xr, gs, shv, lane, ws_ + WS_H8 + (size_t)m * D, (float*)(ws_ + WS_HS) + m);
            else { float* orow = a.out + (size_t)m * D; f32x4 v[8]; float sq = 0.f;
#pragma unroll
                for (int j = 0; j < 8; ++j) { const v2u w = xr[j]; v[j] = (f32x4){bf_lo(w.x), bf_hi(w.x), bf_lo(w.y), bf_hi(w.y)}; sq += (v[j][0] * v[j][0] + v[j][1] * v[j][1]) + (v[j][2] * v[j][2] + v[j][3] * v[j][3]); }
                const float rstd = 1.0f / sqrtf(wave_sum(sq) * (1.0f / D) + EPS);
#pragma unroll
                for (int j = 0; j < 8; ++j) *(f32x4*)(orow + 4 * lane + 256 * j) = v[j] * rstd * gs[j]; }
#pragma unroll
            for (int j = 0; j < 8; ++j) xr[j] = xn[j];
          } }
        }
#undef PF_UCOMPUTE
#undef PF_XCH
#undef PF_IDS
#undef PF_WS
    }
}
#ifndef GATHER_V2
#define GATHER_V2 1
#endif
#ifndef PEER_FUSED
#define PEER_FUSED 1
#endif
constexpr int PPL = PEER_FUSED ? 8 : (GATHER_V2 ? 12 : 9);
constexpr int NPH = 2 + PPL * DEPTH;
#ifndef PH_MASK
#define PH_MASK 0xFFFF
#endif
#define HAS(k) (((PH_MASK) >> (k)) & 1)
#ifndef REP_MASK
#define REP_MASK 0
#endif
#define REPEAT(k) _Pragma("unroll 1") for (int rep_ = 0; rep_ < ((((REP_MASK) >> (k)) & 1) + 1); ++rep_)
#ifndef MK_PER_PHASE
#define MK_PER_PHASE 0
#endif
typedef const __attribute__((address_space(4))) Args* KArgs;
#define PHASE_ENTER() KArgs kp_ = (KArgs)__builtin_amdgcn_kernarg_segment_ptr(); asm volatile("" : "+s"(kp_)); const Args a = *kp_; int tid = threadIdx.x; asm volatile("" : "+v"(tid)); \
    const int lane = tid & 63, wave = __builtin_amdgcn_readfirstlane(tid >> 6); const int G = gridDim.x, bx = blockIdx.x; (void)lane; (void)wave; (void)G; (void)bx; \
    float* modv = (float*)(a.ws + WS_MOD); bf16* H = (bf16*)(a.ws + WS_H); bf16* Z = (bf16*)(a.ws + WS_Z); (void)modv; (void)H; (void)Z;
__global__ void __launch_bounds__(NTHR, 2) mk_fwd(Args a0) {
#if defined(__HIP_DEVICE_COMPILE__)
    extern __shared__ __attribute__((aligned(16))) unsigned char lds_raw[];
    LAS unsigned char* lds = (LAS unsigned char*)lds_raw;
    if (threadIdx.x < 64) ((LAS unsigned*)(lds + MISC_OFF))[threadIdx.x] = 0u;
    __syncthreads();
    const int lo = a0.ph_lo, hi = a0.ph_hi;
    XcdBarrier bar; bar.bar = (unsigned*)(a0.ws + WS_CTL); bar.x = 0; bar.st = (volatile LAS unsigned*)(lds + MISC_OFF + 32);
    if (threadIdx.x == 0) { const unsigned x = xb_xcc_id() & 7u; volatile LAS unsigned* mz = (volatile LAS unsigned*)(lds + MISC_OFF);
        mz[4] = x; mz[5] = __hip_atomic_fetch_add((unsigned*)(a0.ws + WS_CTL) + CW_RANK + lo * 256 + x * 16, 1u, __ATOMIC_RELAXED, __HIP_MEMORY_SCOPE_AGENT); }
    __syncthreads();
    if (hi - lo > 1) bar = xcd_barrier_post((unsigned*)(a0.ws + WS_CTL), (volatile LAS unsigned*)(lds + MISC_OFF + 32));
#define IN(k) (lo <= (k) && (k) < hi)
#define SEAM(k) do { if (IN(k) && IN((k) + 1)) xcd_barrier(bar); } while (0)

    if (HAS(11) && IN(0)) { PHASE_ENTER(); REPEAT(11) p0_prologue(a, lds, tid, lane, wave); }
    SEAM(0);
    if (HAS(12) && IN(1)) { PHASE_ENTER(); REPEAT(12) {
#if !WCOL
        w_to_fp8(a, lds, lane, wave);
#endif
        norm_rows8<false>(a.in[0], a.in[4], modv, D, 0, lane, wave, a.ws + WS_H8, (float*)(a.ws + WS_HS)); } }
    SEAM(1);
#define PEER_MAP() PeerMap pm; { const volatile LAS unsigned* mz = (const volatile LAS unsigned*)(lds + MISC_OFF); pm.x = (int)mz[4]; pm.r = (int)mz[5]; int ok = (hi - lo > 1) && (G == 256) && (pm.r < 32); \
            const unsigned* rk = (const unsigned*)(a.ws + WS_CTL) + CW_RANK + lo * 256; for (int xx = 0; xx < 8; ++xx) ok = ok && (__hip_atomic_load(rk + xx * 16, __ATOMIC_RELAXED, __HIP_MEMORY_SCOPE_AGENT) == 32u); pm.fast = ok; }
#ifdef UNROLL_L
#pragma unroll
#else
#pragma unroll 1
#endif
    for (int l = 0; l < DEPTH; ++l) {
        const int pb = 2 + PPL * l;
        if (HAS(0) && IN(pb + 0)) { PHASE_ENTER(); REPEAT(0) {
            pg8::Gemm g{(const bf16*)(a.ws + WS_H8), (const bf16*)(a.ws + WS_WIN + (size_t)l * INC * D), M, INC, D}; pg8::StaticOrder S; S.init(M, INC, G, bx);
            pg8::EpiZ E{Z, INC, 16, (const float*)(a.ws + WS_HS), WCOL ? 1.0f : wscale(a, l, 0), (size_t)(32 * MiB / 2), (bf16*)(a.ws + WS_ZG), 1, WCOL ? (const float*)(a.ws + WS_WSC) + l * WSC_L + WSC_IN : nullptr, UGM ? M : 0};
            pg8::gemm_phase<pg8::EpiZ, pg8::StaticOrder, true, true, 2>(lds, g, S, E, tid);
        } }
        SEAM(pb + 0);
        if (HAS(1) && IN(pb + 1)) { PHASE_ENTER(); PEER_MAP(); REPEAT(1) { ssm_fused(a, lds, l, tid, lane, wave);
#ifdef SSM_TWICE
            ssm_fused(a, lds, l, tid, lane, wave);
#endif
            { PeerMap pg = pm; pg.fast = 0; attn_phase(a, lds, pg, tid, lane, wave);
#ifdef ATTN_TWICE
            attn_phase(a, lds, pg, tid, lane, wave);
#endif
            } } }
        SEAM(pb + 1);
        if (HAS(4) && IN(pb + 2)) { PHASE_ENTER(); REPEAT(4) {
            attn_combine(a, tid);
            pg8::Gemm g{(const bf16*)(a.ws + WS_Y), (const bf16*)(a.ws + WS_WGLU) + (size_t)l * 1024 * 1024, M, 1024, 1024}; pg8::StaticOrder S; S.init(M, 1024, G, bx);
            pg8::EpiMul<0> E{nullptr, 1024, (const bf16*)(a.ws + WS_Y), YGM ? M : 1024, 0, 1.0f, a.ws + WS_YS, 1.0f, nullptr};
            pg8::gemm_phase<pg8::EpiMul<0>, pg8::StaticOrder, false, true, 0, YGM != 0>(lds, g, S, E, tid);
        } }
        SEAM(pb + 2);
        if (HAS(5) && IN(pb + 3)) { PHASE_ENTER(); REPEAT(5) {
            { pg8::Gemm g{(const bf16*)(a.ws + WS_YS), (const bf16*)(a.ws + WS_WBRS + (size_t)l * D * 1024), M, D, 1024}; pg8::StaticOrder S; S.init(M, D, G, bx);
              pg8::EpiMul<1> E{(bf16*)(a.ws + WS_MG), D, (const bf16*)(a.ws + WS_ZG), 4096, 0, GATE_U8 ? 1.0f / 255.0f : 1.0f, nullptr, 1.0f, (const float*)(a.ws + WS_WSC) + l * WSC_L + WSC_BRS};
              pg8::gemm_phase<pg8::EpiMul<1>, pg8::StaticOrder, true, true, true>(lds, g, S, E, tid); }
            { pg8::Gemm g{(const bf16*)(a.ws + WS_YA), (const bf16*)(a.ws + WS_WBRA + (size_t)l * D * 1024), M, D, 1024}; pg8::StaticOrder S; S.init(M, D, G, bx);
              pg8::EpiMul<2> E{(bf16*)(a.ws + WS_MG), D, (const bf16*)(a.ws + WS_ZG), 4096, 2048, (GATE_U8 ? 1.0f / 255.0f : 1.0f) / YA_Q, a.ws + WS_MG8, MG_Q, (const float*)(a.ws + WS_WSC) + l * WSC_L + WSC_BRA};
              pg8::gemm_phase<pg8::EpiMul<2>, pg8::StaticOrder, true, true, true>(lds, g, S, E, tid); }
        } }
        SEAM(pb + 3);
        if (HAS(6) && IN(pb + 4)) { PHASE_ENTER();
            pg8::Gemm g{(const bf16*)(a.ws + WS_MG8), (const bf16*)(a.ws + WS_WOUT + (size_t)l * D * D), M, D, D}; pg8::StaticOrder S; S.init(M, D, G, bx);
            bf16* XB = (bf16*)(a.ws + WS_XB); const float* gm_ = modv + (size_t)l * NB * NMOD + 2 * D; const float cs_ = 1.0f / MG_Q; const float* csv_ = (const float*)(a.ws + WS_WSC) + l * WSC_L + WSC_OUT;
            if (l == 0) { pg8::EpiRes<false> E{(const void*)a.in[0], XB, D, gm_, NMOD, SEQ, cs_, csv_}; pg8::gemm_phase<pg8::EpiRes<false>, pg8::StaticOrder, true, true, true>(lds, g, S, E, tid); }
            else { pg8::EpiRes<true> E{(const void*)XB, XB, D, gm_, NMOD, SEQ, cs_, csv_}; pg8::gemm_phase<pg8::EpiRes<true>, pg8::StaticOrder, true, true, true>(lds, g, S, E, tid); }
        }
        SEAM(pb + 4);
        if (HAS(7) && IN(pb + 5)) { PHASE_ENTER(); REPEAT(7) {
#if WQ_I8
            norm_rows8<true>(a.ws + WS_XB, a.in[5] + (size_t)l * D, modv + (size_t)l * NB * NMOD, 4 * D, 3 * D, lane, wave, a.ws + WS_HQ, (float*)(a.ws + WS_HQS));
#else
            norm_phase<2, true>(a.ws + WS_XB, a.in[5] + (size_t)l * D, modv + (size_t)l * NB * NMOD, 4 * D, 3 * D, H, lane, wave, a.ws + WS_HQ, (float*)(a.ws + WS_HQS));
#endif
        } }
        SEAM(pb + 5);
        if (HAS(8) && IN(pb + 6)) { PHASE_ENTER(); REPEAT(8) {
#if WQ_I8
            pg8::Gemm g{(const bf16*)(a.ws + WS_HQ), (const bf16*)(a.ws + WS_WQ + (size_t)l * D * D), M, D, D}; pg8::StaticOrder S; S.init(M, D, G, bx);
            pg8::EpiZ E{(bf16*)(a.ws + WS_QP), D, 1 << 30, (const float*)(a.ws + WS_HQS), 1.0f, 0, nullptr, 1, (const float*)(a.ws + WS_WSC) + l * WSC_L + WSC_WQ, 0};
            pg8::gemm_phase<pg8::EpiZ, pg8::StaticOrder, true, true, 2>(lds, g, S, E, tid);
#else
            pg8::Gemm g{H, (const bf16*)(a.ws + WS_WQ) + (size_t)l * D * D, M, D, D}; pg8::StaticOrder S; S.init(M, D, G, bx);
            pg8::EpiZ E{(bf16*)(a.ws + WS_QP), D, 1 << 30, nullptr, 1.0f, 0, nullptr, 0, nullptr, 0};
            pg8::gemm_phase<pg8::EpiZ, pg8::StaticOrder, true, true>(lds, g, S, E, tid);
#endif
#if defined(PROBE_DUMMY) && PROBE_DUMMY == 1
            { pg8::EpiZ E2{(bf16*)(a.ws + WS_Z), D, 1 << 30, nullptr, 1.0f, 0, nullptr, 0, nullptr, 0}; pg8::gemm_phase<pg8::EpiZ, pg8::StaticOrder, true, true>(lds, g, S, E2, tid); }
#elif defined(PROBE_DUMMY) && PROBE_DUMMY == 2
            { pg8::EpiNull E2{(float*)(a.ws + WS_Z)}; pg8::gemm_phase<pg8::EpiNull, pg8::StaticOrder, true, true>(lds, g, S, E2, tid); }
#endif
        } }
        SEAM(pb + 6);
#if !PEER_FUSED
        if (HAS(9) && IN(pb + 7)) { PHASE_ENTER(); REPEAT(9) topk_phase(a, lds, l, tid, lane, wave, bx * NWAVES + wave, (M / 32) * 8, G * NWAVES, true); }
        SEAM(pb + 7);
#endif
#if PEER_FUSED
        if (HAS(10) && IN(pb + 7)) { PHASE_ENTER(); peer_fused_phase(a, lds, l, lane, wave); }
        SEAM(pb + 7);
#elif GATHER_V2
        if (HAS(10) && IN(pb + 8)) { PHASE_ENTER(); PEER_MAP(); REPEAT(13) peer_u_phase(a, l, pm, lane, wave); }
        SEAM(pb + 8);
        if (HAS(10) && IN(pb + 9)) { PHASE_ENTER(); REPEAT(14) peer_act_phase(a, l, lane, wave); }
        SEAM(pb + 9);
        if (HAS(10) && IN(pb + 10)) { PHASE_ENTER(); PEER_MAP(); peer_v_phase(a, l, pm, lane, wave); }
        SEAM(pb + 10);
        if (HAS(10) && IN(pb + 11)) { PHASE_ENTER(); peer_norm_phase(a, l, lane, wave); }
        SEAM(pb + 11);
#else
        if (HAS(10) && IN(pb + 8)) { PHASE_ENTER(); gather_phase(a, l, lane, wave); }
        SEAM(pb + 8);
#endif
    }
#ifdef EXTRA_BARRIERS
    if (hi - lo > 1) { for (int i_ = 0; i_ < EXTRA_BARRIERS; ++i_) xcd_barrier(bar); }
#endif
#undef IN
#undef SEAM
#endif
}

extern "C" void kernel_launch(void* const* d_in, const int* in_sizes, int n_in, void* d_out, int out_size, void* d_ws, size_t ws_size, hipStream_t stream) {
    static int grid = 0;
    if (grid == 0) {
        if (n_in != 24 || in_sizes[0] != M * D || out_size != M * D || ws_size < WS_END2) { fprintf(stderr, "kernel_launch: unexpected shapes (n_in %d, in0 %d, out %d, ws %zu < %zu)\n", n_in, n_in > 0 ? in_sizes[0] : -1, out_size, ws_size, (size_t)WS_END2); grid = -1; return; }
        int dev = 0, cus = 0, per_cu = 0;
        if (hipGetDevice(&dev) != hipSuccess || hipDeviceGetAttribute(&cus, hipDeviceAttributeMultiprocessorCount, dev) != hipSuccess) { grid = -1; return; }
        if (hipFuncSetAttribute((const void*)mk_fwd, hipFuncAttributeMaxDynamicSharedMemorySize, LDS_BYTES) != hipSuccess) { fprintf(stderr, "kernel_launch: hipFuncSetAttribute failed\n"); grid = -1; return; }
        if (hipOccupancyMaxActiveBlocksPerMultiprocessor(&per_cu, (const void*)mk_fwd, NTHR, LDS_BYTES) != hipSuccess || per_cu < 1) fprintf(stderr, "kernel_launch: occupancy query says %d\n", per_cu);
        (void)hipGetLastError();
        grid = cus;
    }
    if (grid < 0) return;
    (void)hipMemsetAsync((char*)d_ws + WS_CTL, 0, CTL_ZERO_BYTES, stream);
    Args a{};
    for (int i = 0; i < 24; ++i) a.in[i] = (const float*)d_in[i];
    a.out = (float*)d_out; a.ws = (unsigned char*)d_ws;
#if MK_PER_PHASE
#ifndef DUP_PHASE_MASK
#define DUP_PHASE_MASK 0u
#endif
    for (int ph = 0; ph < NPH; ++ph) { a.ph_lo = ph; a.ph_hi = ph + 1; for (int r = 0; r < 1 + (int)(((unsigned)(DUP_PHASE_MASK) >> ph) & 1u); ++r) hipLaunchKernelGGL(mk_fwd, dim3(grid), dim3(NTHR), LDS_BYTES, stream, a); }
#else
    a.ph_lo = 0; a.ph_hi = NPH; hipLaunchKernelGGL(mk_fwd, dim3(grid), dim3(NTHR), LDS_BYTES, stream, a);
#endif
}
```
